# Optimizing an MI355X kernel written in HIP

```python
import jax, jax.numpy as jnp
from jax import lax
import numpy as np

D_MODEL = 1024
BATCH = 8
SEQ = 2048
DEPTH = 1

CHUNK = 64
Q_BLOCK = 128
SB_HEADS = 8
SB_HEAD_DIM = 64
SB_WIDTH = SB_HEADS * SB_HEAD_DIM
RET_HEADS = 4
RET_KEY_DIM = 128
RET_VALUE_DIM = 128
RET_QK_WIDTH = RET_HEADS * RET_KEY_DIM
RET_V_WIDTH = RET_HEADS * RET_VALUE_DIM
D_FF = 4 * D_MODEL
RMS_EPS = 1e-6
GN_EPS = 1e-5
ROPE_BASE = 10000.0

SPLIT_SIZES = (SB_WIDTH, SB_WIDTH, SB_WIDTH,
               RET_QK_WIDTH, RET_QK_WIDTH, RET_V_WIDTH, RET_V_WIDTH,
               D_MODEL, D_MODEL)
SPLIT_POINTS = tuple(int(p) for p in np.cumsum(SPLIT_SIZES)[:-1])
W_IN_COLS = int(sum(SPLIT_SIZES))

kernel_name = "sandwich_macaron_stickbreak_retention_hybrid"


def rms_norm(x, g):
    xf = x.astype(jnp.float32)
    y = xf * lax.rsqrt(jnp.mean(xf * xf, axis=-1, keepdims=True) + RMS_EPS)
    return (y * g.astype(jnp.float32)).astype(x.dtype)


def swiglu(h, w_gate, w_up, w_down):
    return (jax.nn.silu(h @ w_gate) * (h @ w_up)) @ w_down


def rotary(x, pos):
    half = x.shape[-1] // 2
    inv_freq = ROPE_BASE ** (-jnp.arange(half, dtype=jnp.float32) / half)
    ang = pos[:, None] * inv_freq[None, :]
    cos = jnp.cos(ang)[None, :, None, :]
    sin = jnp.sin(ang)[None, :, None, :]
    x1, x2 = x[..., :half], x[..., half:]
    return jnp.concatenate([x1 * cos - x2 * sin, x1 * sin + x2 * cos], axis=-1)


def stick_breaking_attention(q, k, v):
    seq = q.shape[1]
    scale = q.shape[-1] ** -0.5
    outs = []
    for i in range(seq // Q_BLOCK):
        start, end = i * Q_BLOCK, (i + 1) * Q_BLOCK
        qb = q[:, start:end]
        kb = k[:, :end]
        vb = v[:, :end]
        z = jnp.einsum('bqhd,bkhd->bhqk', qb, kb) * scale
        t_pos = start + jnp.arange(Q_BLOCK)
        s_pos = jnp.arange(end)
        causal = s_pos[None, :] < t_pos[:, None]
        log_keep = jnp.where(causal, jax.nn.log_sigmoid(-z), 0.0)
        suffix = lax.cumsum(log_keep, axis=3, reverse=True)
        between = jnp.concatenate(
            [suffix[..., 1:], jnp.zeros_like(suffix[..., :1])], axis=-1)
        w = jnp.where(causal, jnp.exp(jax.nn.log_sigmoid(z) + between), 0.0)
        outs.append(jnp.einsum('bhqk,bkhd->bqhd', w, vb))
    return jnp.concatenate(outs, axis=1)


def retention_chunkwise(q, k, v, log_gamma):
    b, seq, h, dk = q.shape
    dv = v.shape[-1]
    n = seq // CHUNK
    qc = q.reshape(b, n, CHUNK, h, dk)
    kc = k.reshape(b, n, CHUNK, h, dk)
    vc = v.reshape(b, n, CHUNK, h, dv)
    idx = jnp.arange(CHUNK, dtype=jnp.float32)
    diff = idx[:, None] - idx[None, :]
    inner_decay = jnp.where(diff[None] >= 0,
                            jnp.exp(jnp.maximum(diff, 0.0)[None] * log_gamma[:, None, None]),
                            0.0)
    scores = jnp.einsum('bnchd,bnmhd->bnhcm', qc, kc) * inner_decay
    inner = jnp.einsum('bnhcm,bnmhe->bnche', scores, vc)
    k_decay = jnp.exp((CHUNK - 1 - idx)[:, None] * log_gamma[None, :])
    chunk_kv = jnp.einsum('bnmhd,bnmhe->nbhde', kc * k_decay[None, None, :, :, None], vc)
    chunk_decay = jnp.exp(CHUNK * log_gamma)[None, :, None, None]

    def step(state, kv):
        return chunk_decay * state + kv, state

    _, prev_states = lax.scan(step, jnp.zeros((b, h, dk, dv), jnp.float32), chunk_kv)
    q_decay = jnp.exp((idx + 1.0)[:, None] * log_gamma[None, :])
    cross = jnp.einsum('bnchd,nbhde->bnche', qc * q_decay[None, None, :, :, None], prev_states)
    return (inner + cross).reshape(b, seq, h, dv)


def head_group_norm(o):
    mu = jnp.mean(o, axis=-1, keepdims=True)
    var = jnp.mean(jnp.square(o - mu), axis=-1, keepdims=True)
    return (o - mu) * lax.rsqrt(var + GN_EPS)


def setup_inputs(seed: int = 0) -> dict:
    key = jax.random.key(seed)
    ks = jax.random.split(key, 20)

    def dense(k, fan_in, fan_out):
        return jax.random.normal(k, (DEPTH, fan_in, fan_out), jnp.float32) * fan_in ** -0.5

    def gain(k):
        return 1.0 + 0.02 * jax.random.normal(k, (DEPTH, D_MODEL), jnp.float32)

    return {
        "x": jax.random.normal(ks[0], (BATCH, SEQ, D_MODEL), jnp.float32),
        "g_ffn1_pre": gain(ks[1]),
        "g_ffn1_post": gain(ks[2]),
        "w_ffn1_gate": dense(ks[3], D_MODEL, D_FF),
        "w_ffn1_up": dense(ks[4], D_MODEL, D_FF),
        "w_ffn1_down": dense(ks[5], D_FF, D_MODEL),
        "g_mix_pre": gain(ks[6]),
        "w_in": dense(ks[7], D_MODEL, W_IN_COLS),
        "w_proj_sb": dense(ks[8], SB_WIDTH, D_MODEL),
        "w_proj_ret": dense(ks[9], RET_V_WIDTH, D_MODEL),
        "w_out": dense(ks[10], D_MODEL, D_MODEL),
        "g_mix_post": gain(ks[11]),
        "g_ffn2_pre": gain(ks[12]),
        "g_ffn2_post": gain(ks[13]),
        "w_ffn2_gate": dense(ks[14], D_MODEL, D_FF),
        "w_ffn2_up": dense(ks[15], D_MODEL, D_FF),
        "w_ffn2_down": dense(ks[16], D_FF, D_MODEL),
    }


def reference(x, g_ffn1_pre, g_ffn1_post, w_ffn1_gate, w_ffn1_up, w_ffn1_down,
              g_mix_pre, w_in, w_proj_sb, w_proj_ret, w_out, g_mix_post,
              g_ffn2_pre, g_ffn2_post, w_ffn2_gate, w_ffn2_up, w_ffn2_down):
    b, seq, _ = x.shape
    f32 = jnp.float32
    pos = jnp.arange(seq, dtype=f32)
    log_gamma = jnp.log(1.0 - 2.0 ** (-5.0 - jnp.arange(RET_HEADS, dtype=f32)))

    for l in range(DEPTH):
        h = rms_norm(x, g_ffn1_pre[l])
        x = x + 0.5 * rms_norm(swiglu(h, w_ffn1_gate[l], w_ffn1_up[l], w_ffn1_down[l]),
                               g_ffn1_post[l])

        h = rms_norm(x, g_mix_pre[l])
        proj = h @ w_in[l]
        (q_sb, k_sb, v_sb, q_r, k_r, v_r, g_r,
         gate_sb, gate_ret) = jnp.split(proj, SPLIT_POINTS, axis=-1)

        shp_sb = (b, seq, SB_HEADS, SB_HEAD_DIM)
        o_sb = stick_breaking_attention(q_sb.reshape(shp_sb).astype(f32),
                                        k_sb.reshape(shp_sb).astype(f32),
                                        v_sb.reshape(shp_sb).astype(f32))
        o_sb = o_sb.reshape(b, seq, SB_WIDTH).astype(x.dtype)

        shp_qk = (b, seq, RET_HEADS, RET_KEY_DIM)
        qr = rotary(q_r.reshape(shp_qk).astype(f32), pos)
        kr = rotary(k_r.reshape(shp_qk).astype(f32), pos) * RET_KEY_DIM ** -0.5
        vr = v_r.reshape(b, seq, RET_HEADS, RET_VALUE_DIM).astype(f32)
        o_r = head_group_norm(retention_chunkwise(qr, kr, vr, log_gamma))
        o_r = (o_r.reshape(b, seq, RET_V_WIDTH) * jax.nn.silu(g_r.astype(f32))).astype(x.dtype)

        merged = (jax.nn.sigmoid(gate_sb) * (o_sb @ w_proj_sb[l])
                  + jax.nn.sigmoid(gate_ret) * (o_r @ w_proj_ret[l]))
        x = x + rms_norm(merged @ w_out[l], g_mix_post[l])

        h = rms_norm(x, g_ffn2_pre[l])
        x = x + 0.5 * rms_norm(swiglu(h, w_ffn2_gate[l], w_ffn2_up[l], w_ffn2_down[l]),
                               g_ffn2_post[l])
    return x
```

```cpp
#include <hip/hip_runtime.h>
#include <cstdio>
#include <cstdint>
#include <cmath>
namespace pg8 {
#define PG8_LAS __attribute__((address_space(3)))
typedef unsigned short bf16_t;
typedef short bf16x8 __attribute__((ext_vector_type(8)));
typedef float f32x4 __attribute__((ext_vector_type(4)));
typedef unsigned u32x4 __attribute__((ext_vector_type(4)));
constexpr int BM = 256, BK = 64, HALF = 128, HTB = HALF * BK * 2  , STAGE_BYTES = 8 * HTB, NXCD = 8, WGM = 8;

__host__ __device__ __forceinline__ int lds_byte(int r, int c) { const int st = (r >> 4) * 2 + (c >> 5), rr = r & 15, cc = c & 31, ob = rr * 64 + cc * 2; return st * 1024 + (ob ^ (((ob >> 9) & 1) << 5)); }
__host__ __device__ __forceinline__ void stage_rc(int b, int& R, int& C) { const int st = b / 1024, sb = b % 1024, swz = sb ^ (((sb >> 9) & 1) << 5); R = (st >> 1) * 16 + swz / 64; C = (st & 1) * 32 + (swz % 64) / 2; }
__host__ __device__ __forceinline__ int perm32(int rho) { const int n = rho >> 4, i = rho & 15; return 8 * (i >> 2) + 4 * n + (i & 3); }

struct Unit { int pm, pn; };
struct Gemm { const bf16_t* A; const bf16_t* Bt; int M, N, K; };

struct StaticOrder {
    int nM, nN, nwg, G, c;
    __host__ __device__ void init(int M, int N, int G_, int c_) { nM = M / BM; nN = N / BM; nwg = nM * nN; G = G_; c = c_; }
    __host__ __device__ bool next(int i, Unit& u) const {
        const long L = (long)i * G + c; if (L >= nwg) return false;
        int wgid = (int)L; { const int q = nwg / NXCD, r = nwg % NXCD, xcd = wgid % NXCD, off = wgid / NXCD; wgid = (xcd < r ? xcd * (q + 1) : r * (q + 1) + (xcd - r) * q) + off; }
        const int nig = WGM * nN, gid = wgid / nig, fm = gid * WGM, gsz = (nM - fm) < WGM ? (nM - fm) : WGM;
        u.pm = fm + ((wgid % nig) % gsz); u.pn = (wgid % nig) / gsz; return true;
    }
    __device__ __forceinline__ void a_ready(const Unit&) const {}
    __device__ __forceinline__ void done(const Unit&) const {}
};

__device__ __forceinline__ unsigned cvt_pk_bf16(float lo, float hi) { unsigned r; asm volatile("v_cvt_pk_bf16_f32 %0, %1, %2" : "=v"(r) : "v"(lo), "v"(hi)); return r; }
typedef float f32x2 __attribute__((ext_vector_type(2)));

__device__ __forceinline__ float fast_sigmoid(float x) { return __builtin_amdgcn_rcpf(1.0f + __expf(-x)); }
__device__ __forceinline__ float bf_lo(unsigned w) { return __uint_as_float(w << 16); }
__device__ __forceinline__ float bf_hi(unsigned w) { return __uint_as_float(w & 0xffff0000u); }

struct EpiSwiGLU {
    static constexpr bool PERM = true, AFTER_DRAIN = false;
    bf16_t* O; int ldc;
    __device__ __forceinline__ void operator()(const f32x4 (&acc)[2][2][4][2], const Unit& u, int wr, int wc, int fr, int fq) const {
        const int row0 = u.pm * BM + wr * 64 + fr, col0 = u.pn * HALF + wc * 32 + 8 * fq;
#pragma unroll
        for (int ai = 0; ai < 2; ++ai)
#pragma unroll
            for (int m = 0; m < 4; ++m) {
                bf16_t* rowp = O + (size_t)(row0 + ai * HALF + m * 16) * ldc + col0;
                float v[8];
#pragma unroll
                for (int n = 0; n < 2; ++n)
#pragma unroll
                    for (int e = 0; e < 4; ++e) { const float g = acc[ai][0][m][n][e], up = acc[ai][1][m][n][e]; v[4 * n + e] = g * fast_sigmoid(g) * up; }
                u32x4 w; w.x = cvt_pk_bf16(v[0], v[1]); w.y = cvt_pk_bf16(v[2], v[3]); w.z = cvt_pk_bf16(v[4], v[5]); w.w = cvt_pk_bf16(v[6], v[7]);
                *(u32x4*)rowp = w;
            }
    }
};

struct EpiF32 {
    static constexpr bool PERM = false, AFTER_DRAIN = false;
    float* O; int ldc;
    __device__ __forceinline__ void operator()(const f32x4 (&acc)[2][2][4][2], const Unit& u, int wr, int wc, int fr, int fq) const {
        const int row0 = u.pm * BM + wr * 64 + fr, col0 = u.pn * BM + wc * 32 + 4 * fq;
#pragma unroll
        for (int ai = 0; ai < 2; ++ai)
#pragma unroll
            for (int m = 0; m < 4; ++m) {
                float* rowp = O + (size_t)(row0 + ai * HALF + m * 16) * ldc + col0;
#pragma unroll
                for (int bj = 0; bj < 2; ++bj)
#pragma unroll
                    for (int n = 0; n < 2; ++n) *(f32x4*)(rowp + bj * HALF + n * 16) = acc[ai][bj][m][n];
            }
    }
};

struct EpiProj {
    static constexpr bool PERM = true, AFTER_DRAIN = false;
    bf16_t* QKVS; bf16_t* RET; bf16_t* GATES; const float* ropec; const float* ropes;
    __device__ __forceinline__ void operator()(const f32x4 (&acc)[2][2][4][2], const Unit& u, int wr, int wc, int fr, int fq) const {
        const int row0 = u.pm * BM + wr * 64 + fr; const int pn = u.pn;
        if (pn >= 6 && pn < 10) {
            const float sc = (pn >= 8) ? 0.08838834764831845f : 1.0f;
            const int hl = wc >> 1, i0 = 32 * (wc & 1) + 8 * fq;
            const int colb = (pn - 6) * BM + hl * 128 + i0;
#pragma unroll
            for (int ai = 0; ai < 2; ++ai)
#pragma unroll
                for (int m = 0; m < 4; ++m) {
                    const int row = row0 + ai * HALF + m * 16; const int pos = row & 2047;
                    const f32x4 c0 = *(const f32x4*)(ropec + pos * 64 + i0), c1 = *(const f32x4*)(ropec + pos * 64 + i0 + 4);
                    const f32x4 s0 = *(const f32x4*)(ropes + pos * 64 + i0), s1 = *(const f32x4*)(ropes + pos * 64 + i0 + 4);
                    float o1[8], o2[8];
#pragma unroll
                    for (int n = 0; n < 2; ++n)
#pragma unroll
                        for (int e = 0; e < 4; ++e) { const float x1 = acc[ai][0][m][n][e], x2 = acc[ai][1][m][n][e]; const float c = n ? c1[e] : c0[e], s = n ? s1[e] : s0[e];
                            o1[4 * n + e] = (x1 * c - x2 * s) * sc; o2[4 * n + e] = (x1 * s + x2 * c) * sc; }
                    bf16_t* rowp = RET + (size_t)row * 2048 + colb;
                    u32x4 w; w.x = cvt_pk_bf16(o1[0], o1[1]); w.y = cvt_pk_bf16(o1[2], o1[3]); w.z = cvt_pk_bf16(o1[4], o1[5]); w.w = cvt_pk_bf16(o1[6], o1[7]);
                    *(u32x4*)rowp = w;
                    w.x = cvt_pk_bf16(o2[0], o2[1]); w.y = cvt_pk_bf16(o2[2], o2[3]); w.z = cvt_pk_bf16(o2[4], o2[5]); w.w = cvt_pk_bf16(o2[6], o2[7]);
                    *(u32x4*)(rowp + 64) = w;
                }
            return;
        }
        bf16_t* base; int ldc, colt; float sc = 1.0f;
        if (pn < 6) { base = QKVS; ldc = 1536; colt = pn * BM; if (pn < 2) sc = 0.125f; }
        else if (pn < 14) { base = RET; ldc = 2048; colt = (pn - 6) * BM; }
        else { base = GATES; ldc = 2048; colt = (pn - 14) * BM; }
        const int col0 = colt + wc * 32 + 8 * fq;
#pragma unroll
        for (int ai = 0; ai < 2; ++ai)
#pragma unroll
            for (int m = 0; m < 4; ++m) { bf16_t* rowp = base + (size_t)(row0 + ai * HALF + m * 16) * ldc + col0;
#pragma unroll
                for (int bj = 0; bj < 2; ++bj) { const f32x4 v0 = acc[ai][bj][m][0] * sc, v1 = acc[ai][bj][m][1] * sc;
                    u32x4 w; w.x = cvt_pk_bf16(v0[0], v0[1]); w.y = cvt_pk_bf16(v0[2], v0[3]); w.z = cvt_pk_bf16(v1[0], v1[1]); w.w = cvt_pk_bf16(v1[2], v1[3]);
                    *(u32x4*)(rowp + bj * HALF) = w; } }
    }
};

struct EpiMerge {
    static constexpr bool PERM = true, AFTER_DRAIN = false;
    bf16_t* O; const bf16_t* GATES;
    __device__ __forceinline__ void operator()(const f32x4 (&acc)[2][2][4][2], const Unit& u, int wr, int wc, int fr, int fq) const {
        const int row0 = u.pm * BM + wr * 64 + fr, col0 = u.pn * HALF + wc * 32 + 8 * fq;
#pragma unroll
        for (int ai = 0; ai < 2; ++ai)
#pragma unroll
            for (int m = 0; m < 4; ++m) {
                const size_t row = (size_t)(row0 + ai * HALF + m * 16);
                const u32x4 ga = *(const u32x4*)(GATES + row * 2048 + col0), gb = *(const u32x4*)(GATES + row * 2048 + 1024 + col0);
                float a[8], b[8];
                a[0] = bf_lo(ga.x); a[1] = bf_hi(ga.x); a[2] = bf_lo(ga.y); a[3] = bf_hi(ga.y); a[4] = bf_lo(ga.z); a[5] = bf_hi(ga.z); a[6] = bf_lo(ga.w); a[7] = bf_hi(ga.w);
                b[0] = bf_lo(gb.x); b[1] = bf_hi(gb.x); b[2] = bf_lo(gb.y); b[3] = bf_hi(gb.y); b[4] = bf_lo(gb.z); b[5] = bf_hi(gb.z); b[6] = bf_lo(gb.w); b[7] = bf_hi(gb.w);
                float v[8];
#pragma unroll
                for (int n = 0; n < 2; ++n)
#pragma unroll
                    for (int e = 0; e < 4; ++e) v[4 * n + e] = fast_sigmoid(a[4 * n + e]) * acc[ai][0][m][n][e] + fast_sigmoid(b[4 * n + e]) * acc[ai][1][m][n][e];
                u32x4 w; w.x = cvt_pk_bf16(v[0], v[1]); w.y = cvt_pk_bf16(v[2], v[3]); w.z = cvt_pk_bf16(v[4], v[5]); w.w = cvt_pk_bf16(v[6], v[7]);
                *(u32x4*)(O + row * 1024 + col0) = w;
            }
    }
};
template <class Epi, class Sched, bool ALIGN_EPI = false, bool SP2 = false>
__device__ __forceinline__ void gemm_phase(PG8_LAS unsigned char* lds, const Gemm g, const Sched& S, const Epi& E) {
    const int tid = threadIdx.x, wid = __builtin_amdgcn_readfirstlane(tid >> 6), lane = tid & 63, wr = wid >> 2, wc = wid & 3, fr = lane & 15, fq = lane >> 4;
    const int K = g.K, nt = K / BK;
    unsigned voffA[2], voffB[2];
#pragma unroll
    for (int i = 0; i < 2; ++i) { int R, C; stage_rc(tid * 16 + i * 8192, R, C); const int Rb = Epi::PERM ? ((R & ~31) + perm32(R & 31)) : R;
        voffA[i] = (unsigned)(R * K + C) * 2u; voffB[i] = (unsigned)(Rb * K + C) * 2u; }
    const size_t kstep = (size_t)(BK * 2);
    const size_t hstep = (size_t)HALF * K * 2;
    const size_t tstep = 2 * hstep;
    const unsigned ldsw = (unsigned)wid * 1024u;
    const int aoff = lds_byte(wr * 64 + fr, fq * 8), boff = lds_byte(wc * 32 + fr, fq * 8);
#define PG8_SA(b, h) (((b) * 2 + (h)) * HTB)
#define PG8_SB(b, h) ((4 + (b) * 2 + (h)) * HTB)
#define PG8_STAGE(bufoff, gbase, voff) do { _Pragma("unroll") for (int _i = 0; _i < 2; ++_i) \
        __builtin_amdgcn_global_load_lds((const unsigned*)((const char*)(gbase) + (voff)[_i]), (PG8_LAS unsigned*)(lds + (bufoff) + ldsw + _i * 8192), 16, 0, 0); } while (0)
#define PG8_LDA(dst, b, h) do { _Pragma("unroll") for (int m = 0; m < 4; ++m) _Pragma("unroll") for (int k = 0; k < 2; ++k) dst[m][k] = *(const PG8_LAS bf16x8*)(lds + PG8_SA(b, h) + aoff + m * 2048 + k * 1024); } while (0)
#define PG8_LDB(dst, b, h) do { _Pragma("unroll") for (int n = 0; n < 2; ++n) _Pragma("unroll") for (int k = 0; k < 2; ++k) dst[n][k] = *(const PG8_LAS bf16x8*)(lds + PG8_SB(b, h) + boff + n * 2048 + k * 1024); } while (0)
#define PG8_MMA(ai, bj, At, Bt) do { __builtin_amdgcn_s_setprio(1); _Pragma("unroll") for (int m = 0; m < 4; ++m) _Pragma("unroll") for (int n = 0; n < 2; ++n) _Pragma("unroll") for (int k = 0; k < 2; ++k) \
        acc[ai][bj][m][n] = __builtin_amdgcn_mfma_f32_16x16x32_bf16(Bt[n][k], At[m][k], acc[ai][bj][m][n], 0, 0, 0); __builtin_amdgcn_s_setprio(0); } while (0)
#define PG8_WAIT_V(n) asm volatile("s_waitcnt vmcnt(" #n ")" ::: "memory")
#define PG8_WAIT_L(n) asm volatile("s_waitcnt lgkmcnt(" #n ")" ::: "memory")
#define PG8_BAR __builtin_amdgcn_s_barrier()
#define PG8_SCHED __builtin_amdgcn_sched_barrier(0)
    Unit cur, nxt; int ui = 0;
    if (!S.next(0, cur)) return;
    f32x4 acc[2][2][4][2];
#pragma unroll
    for (int a = 0; a < 2; ++a)
#pragma unroll
        for (int b = 0; b < 2; ++b)
#pragma unroll
            for (int m = 0; m < 4; ++m)
#pragma unroll
                for (int n = 0; n < 2; ++n) acc[a][b][m][n] = (f32x4){0.f, 0.f, 0.f, 0.f};
    bf16x8 At[4][2], B0[2][2], B1[2][2];
    const char* cA = (const char*)g.A + (size_t)cur.pm * tstep; const char* cB = (const char*)g.Bt + (size_t)cur.pn * tstep;
    S.a_ready(cur);
    if constexpr (SP2) {
        PG8_STAGE(PG8_SB(0, 0), cB, voffB); PG8_STAGE(PG8_SB(0, 1), cB + hstep, voffB); PG8_STAGE(PG8_SA(0, 0), cA, voffA); PG8_STAGE(PG8_SA(0, 1), cA + hstep, voffA);
        if (wr == 1) PG8_BAR;
        PG8_WAIT_V(2); PG8_BAR;
        PG8_STAGE(PG8_SB(1, 0), cB + kstep, voffB); PG8_STAGE(PG8_SA(1, 0), cA + kstep, voffA); PG8_STAGE(PG8_SB(1, 1), cB + hstep + kstep, voffB);
        PG8_WAIT_V(6); PG8_BAR;
    } else {
        PG8_STAGE(PG8_SB(0, 0), cB, voffB); PG8_STAGE(PG8_SA(0, 0), cA, voffA); PG8_STAGE(PG8_SB(0, 1), cB + hstep, voffB); PG8_STAGE(PG8_SA(0, 1), cA + hstep, voffA);
        if (wr == 1) PG8_BAR;
        PG8_WAIT_V(4); PG8_BAR;
        PG8_STAGE(PG8_SB(1, 0), cB + kstep, voffB); PG8_STAGE(PG8_SA(1, 0), cA + kstep, voffA); PG8_STAGE(PG8_SB(1, 1), cB + hstep + kstep, voffB);
        PG8_WAIT_V(6); PG8_BAR;
    }
    for (;;) {
        const bool has_next = S.next(ui + 1, nxt);
        const char* nA = has_next ? (const char*)g.A + (size_t)nxt.pm * tstep : cA; const char* nB = has_next ? (const char*)g.Bt + (size_t)nxt.pn * tstep : cB;
        for (int t = 0; t < nt; t += 2) {
            const bool last = (t == nt - 2);
            const char* a1 = cA + (size_t)(t + 1) * kstep;
            const char* a2 = last ? nA : cA + (size_t)(t + 2) * kstep; const char* b2 = last ? nB : cB + (size_t)(t + 2) * kstep;
            const char* a3 = a2 + kstep; const char* b3 = b2 + kstep;
            if (last && has_next) S.a_ready(nxt);
            if constexpr (SP2) {
            PG8_LDB(B0, 0, 0); PG8_LDB(B1, 0, 1); PG8_SCHED; PG8_LDA(At, 0, 0); PG8_STAGE(PG8_SA(1, 1), a1 + hstep, voffA);
            PG8_WAIT_V(8); PG8_WAIT_L(0); PG8_BAR; PG8_MMA(0, 0, At, B0); PG8_MMA(0, 1, At, B1); PG8_BAR; PG8_SCHED;
            PG8_LDA(At, 0, 1); PG8_STAGE(PG8_SB(0, 0), b2, voffB); PG8_STAGE(PG8_SB(0, 1), b2 + hstep, voffB); PG8_STAGE(PG8_SA(0, 0), a2, voffA);
            PG8_WAIT_V(8); PG8_WAIT_L(0); PG8_BAR; PG8_MMA(1, 0, At, B0); PG8_MMA(1, 1, At, B1); PG8_BAR; PG8_SCHED;
            PG8_LDB(B0, 1, 0); PG8_LDB(B1, 1, 1); PG8_SCHED; PG8_LDA(At, 1, 0); PG8_STAGE(PG8_SA(0, 1), a2 + hstep, voffA);
            PG8_WAIT_V(8); PG8_WAIT_L(0); PG8_BAR; PG8_MMA(0, 0, At, B0); PG8_MMA(0, 1, At, B1); PG8_BAR; PG8_SCHED;
            PG8_LDA(At, 1, 1); PG8_STAGE(PG8_SB(1, 0), b3, voffB); PG8_STAGE(PG8_SB(1, 1), b3 + hstep, voffB); PG8_STAGE(PG8_SA(1, 0), a3, voffA);
            PG8_WAIT_V(8); PG8_WAIT_L(0); PG8_BAR; PG8_MMA(1, 0, At, B0); PG8_MMA(1, 1, At, B1); PG8_BAR; PG8_SCHED;
            } else {
            PG8_LDB(B0, 0, 0); PG8_SCHED; PG8_LDA(At, 0, 0); PG8_STAGE(PG8_SA(1, 1), a1 + hstep, voffA);
            PG8_WAIT_L(8); PG8_BAR; PG8_WAIT_L(0); PG8_MMA(0, 0, At, B0); PG8_BAR; PG8_SCHED;
            PG8_LDB(B1, 0, 1); PG8_STAGE(PG8_SB(0, 0), b2, voffB);
            PG8_BAR; PG8_WAIT_L(0); PG8_MMA(0, 1, At, B1); PG8_BAR;
            PG8_LDA(At, 0, 1); PG8_STAGE(PG8_SA(0, 0), a2, voffA);
            PG8_BAR; PG8_WAIT_L(0); PG8_MMA(1, 0, At, B0); PG8_BAR; PG8_SCHED;
            PG8_STAGE(PG8_SB(0, 1), b2 + hstep, voffB);
            PG8_WAIT_V(6); PG8_BAR; PG8_MMA(1, 1, At, B1); PG8_BAR;
            PG8_LDB(B0, 1, 0); PG8_SCHED; PG8_LDA(At, 1, 0); PG8_STAGE(PG8_SA(0, 1), a2 + hstep, voffA);
            PG8_WAIT_L(8); PG8_BAR; PG8_WAIT_L(0); PG8_MMA(0, 0, At, B0); PG8_BAR; PG8_SCHED;
            PG8_LDB(B1, 1, 1); PG8_STAGE(PG8_SB(1, 0), b3, voffB);
            PG8_BAR; PG8_WAIT_L(0); PG8_MMA(0, 1, At, B1); PG8_BAR;
            PG8_LDA(At, 1, 1); PG8_STAGE(PG8_SA(1, 0), a3, voffA);
            PG8_BAR; PG8_WAIT_L(0); PG8_MMA(1, 0, At, B0); PG8_BAR; PG8_SCHED;
            PG8_STAGE(PG8_SB(1, 1), b3 + hstep, voffB);
            PG8_WAIT_V(6); PG8_BAR; PG8_MMA(1, 1, At, B1); PG8_BAR;
            }
        }
        if constexpr (ALIGN_EPI) { if (wr == 0) PG8_BAR; }
        if constexpr (!Epi::AFTER_DRAIN) { E(acc, cur, wr, wc, fr, fq); S.done(cur); }
        if (!has_next) break;
#pragma unroll
        for (int a = 0; a < 2; ++a)
#pragma unroll
            for (int b = 0; b < 2; ++b)
#pragma unroll
                for (int m = 0; m < 4; ++m)
#pragma unroll
                    for (int n = 0; n < 2; ++n) acc[a][b][m][n] = (f32x4){0.f, 0.f, 0.f, 0.f};
        cur = nxt; cA = nA; cB = nB; ++ui;
        if constexpr (ALIGN_EPI) { if (wr == 1) PG8_BAR; }
    }
    PG8_WAIT_V(0);
    if constexpr (!ALIGN_EPI) { if (wr == 0) PG8_BAR; }
    PG8_BAR;
    if constexpr (Epi::AFTER_DRAIN) { E.fused(acc, cur, wr, wc, fr, fq, lds, wid, lane); S.done(cur); }
#undef PG8_SA
#undef PG8_SB
#undef PG8_STAGE
#undef PG8_LDA
#undef PG8_LDB
#undef PG8_MMA
#undef PG8_WAIT_V
#undef PG8_WAIT_L
#undef PG8_BAR
#undef PG8_SCHED
}
}
#define GAS __attribute__((address_space(1)))
#define LAS __attribute__((address_space(3)))
typedef unsigned short bf16;
typedef unsigned v4u __attribute__((ext_vector_type(4)));
typedef float f32x4 __attribute__((ext_vector_type(4)));
typedef short bf16x8 __attribute__((ext_vector_type(8)));
typedef GAS unsigned gu32;
typedef GAS unsigned long long gu64;
#define RLX_AGENT __ATOMIC_RELAXED, __HIP_MEMORY_SCOPE_AGENT
#define LDS_WAIT() asm volatile("s_waitcnt lgkmcnt(0)" ::: "memory")
#define VM_WAIT() asm volatile("s_waitcnt vmcnt(0)" ::: "memory")
__device__ __forceinline__ unsigned long long rt() { return __builtin_amdgcn_s_memrealtime(); }
__device__ __forceinline__ unsigned f2bf(float f) { unsigned u = __builtin_bit_cast(unsigned, f); return (u + 0x7fffu + ((u >> 16) & 1u)) >> 16; }
__device__ __forceinline__ unsigned pk2(float lo, float hi) { return f2bf(lo) | (f2bf(hi) << 16); }

#define XB_TMO      128
#define XB_XCNT(j)  (256  + 64 * (j))
#define XB_XSUB(j)  (1280 + 64 * (j))
#define XB_XGEN(j)  (2304 + 64 * (j))
#define XB_TOP      3328
#define XB_TOPGEN   3392
#define XCD_BAR_WORDS 3456
#define XB_SPIN_CAP (1u << 18)

__device__ __forceinline__ unsigned xb_ld(unsigned* p)              { return __hip_atomic_load(p, __ATOMIC_RELAXED, __HIP_MEMORY_SCOPE_AGENT); }
__device__ __forceinline__ unsigned xb_add(unsigned* p, unsigned v) { return __hip_atomic_fetch_add(p, v, __ATOMIC_RELAXED, __HIP_MEMORY_SCOPE_AGENT); }
__device__ __forceinline__ unsigned xb_xcc_id() { return (unsigned)__builtin_amdgcn_s_getreg((3 << 11) | 20) & 0xFu; }
#define XB_SPIN(cond, bar) do { unsigned _sp = 0; while (cond) { __builtin_amdgcn_s_sleep(1); \
    if ((++_sp & 255u) == 0u) { if (xb_ld(&(bar)[XB_TMO])) break; if (_sp > XB_SPIN_CAP) { atomicAdd(&(bar)[XB_TMO], 1u); break; } } } } while (0)

struct XcdBarrier {
    unsigned* bar; unsigned x;
    volatile LAS unsigned* st;
};

__device__ __forceinline__ XcdBarrier xcd_barrier_post(unsigned* bar, volatile LAS unsigned* st) {
    XcdBarrier b; b.bar = bar; b.x = xb_xcc_id(); b.st = st;
    if (threadIdx.x == 0) (void)xb_add(&bar[XB_XCNT(b.x)], 1u);
    return b;
}
__device__ __forceinline__ void xcd_barrier_complete(unsigned* bar, unsigned x, unsigned& nloc, unsigned& nx) {
    const unsigned G = gridDim.x * gridDim.y * gridDim.z;
    unsigned sum, cnt, mine, sp = 0u;
    for (;;) {
        sum = 0u; cnt = 0u; mine = 0u;
#pragma unroll
        for (unsigned j = 0; j < 16; ++j) { const unsigned c = xb_ld(&bar[XB_XCNT(j)]); sum += c; cnt += (c > 0u) ? 1u : 0u; mine = (j == x) ? c : mine; }
        if (sum == G) break;
        __builtin_amdgcn_s_sleep(1);
        if ((++sp & 255u) == 0u) { if (xb_ld(&bar[XB_TMO])) break; if (sp > XB_SPIN_CAP) { atomicAdd(&bar[XB_TMO], 1u); break; } }
    }
    nloc = mine > 0u ? mine : 1u; nx = cnt > 0u ? cnt : 1u;
}

__device__ __forceinline__ void xcd_barrier(const XcdBarrier& b) {
    asm volatile("s_waitcnt vmcnt(0)" ::: "memory");
    __syncthreads();
    if (threadIdx.x == 0) {
        unsigned* bar = b.bar;
        __builtin_amdgcn_s_waitcnt(0);
        unsigned nloc = b.st[0], nx = b.st[1];
        if (nloc == 0u) { xcd_barrier_complete(bar, b.x, nloc, nx); b.st[0] = nloc; b.st[1] = nx; }
        const unsigned old = xb_add(&bar[XB_XSUB(b.x)], 1u);
        const unsigned gen = old / nloc;
        if (old + 1u == (gen + 1u) * nloc) {
            __builtin_amdgcn_fence(__ATOMIC_RELEASE, "agent");
            asm volatile("s_waitcnt vmcnt(0)" ::: "memory");
            const unsigned og = xb_add(&bar[XB_TOP], 1u);
            const unsigned tg = og / nx;
            if (og + 1u == (tg + 1u) * nx) xb_add(&bar[XB_TOPGEN], 1u);
            else XB_SPIN(xb_ld(&bar[XB_TOPGEN]) == tg, bar);
            __builtin_amdgcn_fence(__ATOMIC_ACQUIRE, "agent");
            xb_add(&bar[XB_XGEN(b.x)], 1u);
            asm volatile("s_waitcnt vmcnt(0)" ::: "memory");
        } else {
            XB_SPIN(xb_ld(&bar[XB_XGEN(b.x)]) == gen, bar);
            __builtin_amdgcn_fence(__ATOMIC_ACQUIRE, "agent");
            asm volatile("s_waitcnt vmcnt(0)" ::: "memory");
        }
    }
    __syncthreads();
}

constexpr int NWAVES = 8;
#ifndef MK_N_LAUNCHES
#define MK_N_LAUNCHES 12
#endif
constexpr int N_LAUNCHES = MK_N_LAUNCHES;
constexpr int NPHASE = 12;
constexpr int BATCH = 8, SEQ = 2048, D = 1024, FF = 4096, M = BATCH * SEQ;
constexpr int NPROJ = 5632;
constexpr float RMS_EPS = 1e-6f, GN_EPS = 1e-5f;

constexpr size_t MiB = 1u << 20;
constexpr size_t WS_CTL = 0, CTL_ZERO_BYTES = 1 * MiB;
constexpr size_t WS_ROPE = 1 * MiB;
constexpr size_t WS_WD = 2 * MiB;
constexpr size_t WS_H = 10 * MiB;
constexpr size_t WS_WIN = 42 * MiB;
constexpr size_t WS_WP = 53 * MiB;
constexpr size_t WS_WOUT = 57 * MiB;
constexpr size_t WS_WGU = 59 * MiB;
constexpr size_t WS_Y2 = 10 * MiB;
constexpr size_t WS_BIG = 75 * MiB;
constexpr size_t WS_ACT = WS_BIG;
constexpr size_t WS_QKVS = WS_BIG;
constexpr size_t WS_RET = WS_BIG + 48 * MiB;
constexpr size_t WS_GATES = WS_BIG + 112 * MiB;
constexpr size_t WS_MERGED = WS_BIG;
constexpr size_t WS_Z = WS_BIG + 48 * MiB;
constexpr size_t WS_END = 251 * MiB;
static_assert(WS_Y2 + (size_t)M * D * 4 <= WS_BIG && WS_GATES + (size_t)M * 2048 * 2 <= WS_END && WS_WGU + (size_t)8192 * 1024 * 2 <= WS_BIG, "ws map");
constexpr int CW_TMO = 0, CW_CODE = 1;
constexpr int CW_BAR = 4096;

constexpr int RING_OFF = 0, RING_BYTES = 131072;
constexpr int LDSCTL_OFF = RING_BYTES, MISC_OFF = LDSCTL_OFF + 320;
constexpr int LDS_BYTES = 147456;

struct Frame {
    LAS unsigned char* lds;
    volatile LAS unsigned* MISC;
    gu32* ctl;
    int tid, lane, wave;
    int vcu, G;
    const float* x; float* out;
    const float *g_ffn1_pre, *g_ffn1_post, *w1g, *w1u, *w1d, *g_mix_pre, *w_in, *w_psb, *w_pret, *w_out, *g_mix_post, *g_ffn2_pre, *g_ffn2_post, *w2g, *w2u, *w2d;
    unsigned char* ws;
};

__device__ __forceinline__ float wave_sum(float v) {
#pragma unroll
    for (int o = 1; o < 64; o <<= 1) v += __shfl_xor(v, o);
    return v;
}

__device__ __forceinline__ void tr_block(const float* W, int ldw, int k0, int n0, bf16* WT, int ldt, int drow0, int dk0, LAS float* scr, int lane) {
#pragma unroll 8
    for (int i = 0; i < 32; ++i) { const int kk = 2 * i + (lane >> 5); scr[kk * 33 + (lane & 31)] = W[(size_t)(k0 + kk) * ldw + n0 + (lane & 31)]; }
    LDS_WAIT(); asm volatile("" ::: "memory");
    const int c = lane & 7;
#pragma unroll
    for (int j = 0; j < 4; ++j) { const int n = (lane >> 3) + 8 * j; const LAS float* s = scr + (8 * c) * 33 + n;
        v4u o; o.x = pk2(s[0 * 33], s[1 * 33]); o.y = pk2(s[2 * 33], s[3 * 33]); o.z = pk2(s[4 * 33], s[5 * 33]); o.w = pk2(s[6 * 33], s[7 * 33]);
        *(GAS v4u*)(WT + (size_t)(drow0 + n) * ldt + dk0 + 8 * c) = o; }
    LDS_WAIT(); asm volatile("" ::: "memory");
}
__device__ __forceinline__ void tr_job(int kind, const float* W, int K, int N, bf16* WT, int ldt, int item, LAS float* scr, int lane) {
    const int nblk = N / 32, kb = item / nblk, nb = item % nblk, k0 = 64 * kb, n0 = 32 * nb;
    int drow0 = n0, dk0 = k0;
    if (kind == 1) drow0 = 256 * (n0 >> 7) + (n0 & 127);
    else if (kind == 2) drow0 = 256 * (n0 >> 7) + 128 + (n0 & 127);
    else if (kind == 3) { const int tile = n0 >> 8; if (tile >= 6 && tile < 10) { const int local = n0 & 255, hl = local >> 7, within = local & 127, half = within >> 6, i0 = within & 63; drow0 = 256 * tile + 128 * half + 64 * hl + i0; } }
    else if (kind == 4) drow0 = 256 * (n0 >> 7) + (n0 & 127);
    else if (kind == 5) { drow0 = 256 * (n0 >> 7) + 128 + (n0 & 127); dk0 = 512 + k0; }
    tr_block(W, N, k0, n0, WT, ldt, drow0, dk0, scr, lane);
}

__device__ __forceinline__ void rms_to_bf16(const f32x4 (&v)[4], const float* g, bf16* orow, int lane) {
    float s = 0.f;
#pragma unroll
    for (int j = 0; j < 4; ++j) s += (v[j].x * v[j].x + v[j].y * v[j].y) + (v[j].z * v[j].z + v[j].w * v[j].w);
    const float rs = 1.0f / sqrtf(wave_sum(s) * (1.f / D) + RMS_EPS);
    GAS unsigned long long* o8 = (GAS unsigned long long*)orow + lane;
#pragma unroll
    for (int j = 0; j < 4; ++j) { const f32x4 gg = ((const GAS f32x4*)g)[lane + 64 * j];
        o8[64 * j] = (unsigned long long)pk2(v[j].x * rs * gg.x, v[j].y * rs * gg.y) | ((unsigned long long)pk2(v[j].z * rs * gg.z, v[j].w * rs * gg.w) << 32); }
}
__device__ __forceinline__ void rows_phase(Frame& F, const float* Y, const float* xres, float* xo, const float* g_post, float coef, const float* g_pre, bf16* hn) {
    const int gw = F.vcu * NWAVES + F.wave, NGW = F.G * NWAVES;
    for (int m = gw; m < M; m += NGW) {
        const GAS f32x4* yr = (const GAS f32x4*)(Y + (size_t)m * D) + F.lane;
        const GAS f32x4* xr = (const GAS f32x4*)(xres + (size_t)m * D) + F.lane;
        f32x4 y[4], xv[4]; float s = 0.f;
#pragma unroll
        for (int j = 0; j < 4; ++j) { y[j] = yr[64 * j]; xv[j] = xr[64 * j]; s += (y[j].x * y[j].x + y[j].y * y[j].y) + (y[j].z * y[j].z + y[j].w * y[j].w); }
        const float rs = coef / sqrtf(wave_sum(s) * (1.f / D) + RMS_EPS);
        GAS f32x4* orow = (GAS f32x4*)(xo + (size_t)m * D) + F.lane;
#pragma unroll
        for (int j = 0; j < 4; ++j) { const f32x4 gg = ((const GAS f32x4*)g_post)[F.lane + 64 * j]; xv[j] = xv[j] + y[j] * gg * rs; orow[64 * j] = xv[j]; }
        if (hn) rms_to_bf16(xv, g_pre, hn + (size_t)m * D, F.lane);
    }
}

__device__ __forceinline__ void convert_ffn_weights(Frame& F, const float* wg, const float* wu, const float* wd, LAS float* scr) {
    const int gw = F.vcu * NWAVES + F.wave, NGW = F.G * NWAVES;
    bf16* WGU = (bf16*)(F.ws + WS_WGU); bf16* WD = (bf16*)(F.ws + WS_WD);
    constexpr int I_G = (D / 64) * (FF / 32), I_D = (FF / 64) * (D / 32);
    for (int it = gw; it < 2 * I_G + I_D; it += NGW) {
        int r = it;
        if (r < I_G) { tr_job(1, wg, D, FF, WGU, D, r, scr, F.lane); continue; } r -= I_G;
        if (r < I_G) { tr_job(2, wu, D, FF, WGU, D, r, scr, F.lane); continue; } r -= I_G;
        tr_job(0, wd, FF, D, WD, FF, r, scr, F.lane);
    }
}

__device__ __forceinline__ void p0_prologue(Frame& F) {
    LAS float* scr = (LAS float*)(F.lds + RING_OFF + F.wave * 16384);
    const int gw = F.vcu * NWAVES + F.wave, NGW = F.G * NWAVES;
    convert_ffn_weights(F, F.w1g, F.w1u, F.w1d, scr);
    bf16* WIN = (bf16*)(F.ws + WS_WIN); bf16* WP = (bf16*)(F.ws + WS_WP); bf16* WOUT = (bf16*)(F.ws + WS_WOUT);
    constexpr int I_IN = (D / 64) * (NPROJ / 32), I_P = (512 / 64) * (D / 32), I_O = (D / 64) * (D / 32);
    for (int it = gw; it < I_IN + 2 * I_P + I_O; it += NGW) {
        int r = it;
        if (r < I_IN) { tr_job(3, F.w_in, D, NPROJ, WIN, D, r, scr, F.lane); continue; } r -= I_IN;
        if (r < I_P) { tr_job(4, F.w_psb, 512, D, WP, D, r, scr, F.lane); continue; } r -= I_P;
        if (r < I_P) { tr_job(5, F.w_pret, 512, D, WP, D, r, scr, F.lane); continue; } r -= I_P;
        tr_job(0, F.w_out, D, D, WOUT, D, r, scr, F.lane);
    }
    for (int r = gw; r < 2048; r += NGW) { const int kz = ((r & 255) < 128) ? 512 : 0; *(GAS v4u*)(WP + (size_t)r * 1024 + kz + 8 * F.lane) = (v4u){0u, 0u, 0u, 0u}; }
    { float* ct = (float*)(F.ws + WS_ROPE); float* st = ct + 2048 * 64;
      for (int idx = (F.vcu * NWAVES + F.wave) * 64 + F.lane; idx < 2048 * 64; idx += F.G * NWAVES * 64) {
          const int pos = idx >> 6, i = idx & 63;
          const float inv_freq = exp2f(-(float)i * (13.287712379549449f / 64.0f));
          const float ang = (float)pos * inv_freq;
          const double a = (double)ang; const double k = __builtin_rint(a * 0.15915494309189535);
          const double r = __builtin_fma(-k, 6.283185307179586, a) - k * 2.4492935982947064e-16;
          const float rf = (float)r; ct[idx] = cosf(rf); st[idx] = sinf(rf); } }
    bf16* H = (bf16*)(F.ws + WS_H);
    for (int m = gw; m < M; m += NGW) { const GAS f32x4* xr = (const GAS f32x4*)(F.x + (size_t)m * D) + F.lane; f32x4 v[4];
#pragma unroll
        for (int j = 0; j < 4; ++j) v[j] = xr[64 * j];
        rms_to_bf16(v, F.g_ffn1_pre, H + (size_t)m * D, F.lane); }
}

__device__ __forceinline__ void unpack8(const v4u w, float* f) {
    f[0] = __uint_as_float(w.x << 16); f[1] = __uint_as_float(w.x & 0xffff0000u); f[2] = __uint_as_float(w.y << 16); f[3] = __uint_as_float(w.y & 0xffff0000u);
    f[4] = __uint_as_float(w.z << 16); f[5] = __uint_as_float(w.z & 0xffff0000u); f[6] = __uint_as_float(w.w << 16); f[7] = __uint_as_float(w.w & 0xffff0000u);
}
__device__ __forceinline__ float bf2f(bf16 v) { return __uint_as_float((unsigned)v << 16); }

__device__ __forceinline__ void attn_naive(Frame& F) {
    const bf16* QKVS = (const bf16*)(F.ws + WS_QKVS); bf16* O2 = (bf16*)(F.ws + WS_H);
    const int bx = blockIdx.x;
    for (int bh = bx >> 2; bh < 64; bh += (F.G >> 2)) {
        const int q4 = bx & 3, wv = F.wave;
        const int tb = wv < 4 ? q4 * 4 + wv : 31 - (q4 * 4 + (wv - 4));
        const int t = tb * 64 + F.lane, b = bh >> 3, h = bh & 7;
        const bf16* base = QKVS + (size_t)(b * SEQ) * 1536 + h * 64;
        float q[64], acc[64];
        { const GAS v4u* qp = (const GAS v4u*)(base + (size_t)t * 1536);
#pragma unroll
          for (int j = 0; j < 8; ++j) unpack8(qp[j], q + 8 * j); }
#pragma unroll
        for (int j = 0; j < 64; ++j) acc[j] = 0.f;
        float between = 0.f;
        for (int s = t - 1; s >= 0; --s) {
            const GAS v4u* kp = (const GAS v4u*)(base + (size_t)s * 1536 + 512);
            const GAS v4u* vp = (const GAS v4u*)(base + (size_t)s * 1536 + 1024);
            float z = 0.f;
#pragma unroll
            for (int j = 0; j < 8; ++j) { float kf[8]; unpack8(kp[j], kf);
#pragma unroll
                for (int e = 0; e < 8; ++e) z += q[8 * j + e] * kf[e]; }
            const float lk = -(fmaxf(z, 0.f) + __logf(1.0f + __expf(-fabsf(z))));
            const float w = __expf(z + lk + between);
#pragma unroll
            for (int j = 0; j < 8; ++j) { float vf[8]; unpack8(vp[j], vf);
#pragma unroll
                for (int e = 0; e < 8; ++e) acc[8 * j + e] += w * vf[e]; }
            between += lk;
        }
        GAS v4u* op = (GAS v4u*)(O2 + (size_t)(b * SEQ + t) * 1024 + h * 64);
#pragma unroll
        for (int j = 0; j < 8; ++j) { v4u w; w.x = pk2(acc[8 * j], acc[8 * j + 1]); w.y = pk2(acc[8 * j + 2], acc[8 * j + 3]); w.z = pk2(acc[8 * j + 4], acc[8 * j + 5]); w.w = pk2(acc[8 * j + 6], acc[8 * j + 7]); op[j] = w; }
    }
}

__device__ __forceinline__ void ret_naive(Frame& F) {
    const bf16* RET = (const bf16*)(F.ws + WS_RET); bf16* O2 = (bf16*)(F.ws + WS_H);
    LAS float* red = (LAS float*)(F.lds + RING_OFF);
    for (int bh = blockIdx.x; bh < 32; bh += F.G) {
        const int b = bh >> 2, h = bh & 3;
        const float gamma = 1.0f - exp2f(-5.0f - (float)h);
        const int e = F.tid & 127, dg = F.tid >> 7;
        float S[32];
#pragma unroll
        for (int i = 0; i < 32; ++i) S[i] = 0.f;
        for (int t0 = 0; t0 < SEQ; t0 += 8) {
#pragma unroll 1
            for (int j = 0; j < 8; ++j) {
                const bf16* row = RET + (size_t)(b * SEQ + t0 + j) * 2048;
                const float vv = bf2f(row[1024 + h * 128 + e]);
                const GAS v4u* qp = (const GAS v4u*)(row + h * 128 + 32 * dg);
                const GAS v4u* kp = (const GAS v4u*)(row + 512 + h * 128 + 32 * dg);
                float p = 0.f;
#pragma unroll
                for (int c = 0; c < 4; ++c) { float qf[8], kf[8]; unpack8(qp[c], qf); unpack8(kp[c], kf);
#pragma unroll
                    for (int i = 0; i < 8; ++i) { S[8 * c + i] = gamma * S[8 * c + i] + kf[i] * vv; p += qf[i] * S[8 * c + i]; } }
                red[(j * 4 + dg) * 128 + e] = p;
            }
            __syncthreads();
            { const int j = F.wave; const bf16* row = RET + (size_t)(b * SEQ + t0 + j) * 2048;
              const float o0 = (red[(j * 4 + 0) * 128 + F.lane] + red[(j * 4 + 1) * 128 + F.lane]) + (red[(j * 4 + 2) * 128 + F.lane] + red[(j * 4 + 3) * 128 + F.lane]);
              const float o1 = (red[(j * 4 + 0) * 128 + 64 + F.lane] + red[(j * 4 + 1) * 128 + 64 + F.lane]) + (red[(j * 4 + 2) * 128 + 64 + F.lane] + red[(j * 4 + 3) * 128 + 64 + F.lane]);
              const float mean = wave_sum(o0 + o1) * (1.f / 128.f); const float d0 = o0 - mean, d1 = o1 - mean;
              const float var = wave_sum(d0 * d0 + d1 * d1) * (1.f / 128.f); const float rstd = 1.0f / sqrtf(var + GN_EPS);
              const float g0 = bf2f(row[1536 + h * 128 + F.lane]), g1 = bf2f(row[1536 + h * 128 + 64 + F.lane]);
              bf16* orow = O2 + (size_t)(b * SEQ + t0 + j) * 1024 + 512 + h * 128;
              orow[F.lane] = (bf16)f2bf(d0 * rstd * g0 * pg8::fast_sigmoid(g0)); orow[64 + F.lane] = (bf16)f2bf(d1 * rstd * g1 * pg8::fast_sigmoid(g1)); }
            __syncthreads();
        }
    }
}

struct Args { const float* in[17]; float* out; unsigned char* ws; int ph_lo, ph_hi, li, pad; };
__global__ void __launch_bounds__(NWAVES * 64, 2) skel_fwd(Args args) {
    extern __shared__ __attribute__((aligned(16))) unsigned char lds[];
    Frame F;
    F.lds = (LAS unsigned char*)lds;
    F.MISC = (volatile LAS unsigned*)(F.lds + MISC_OFF);
    F.tid = threadIdx.x; F.lane = F.tid & 63; F.wave = __builtin_amdgcn_readfirstlane(F.tid >> 6);
    F.G = gridDim.x; { const int bx = blockIdx.x; F.vcu = (F.G % 8 == 0) ? (bx % 8) * (F.G / 8) + bx / 8 : bx; }
#define GRID_BAR(seam) do { if (N_LAUNCHES == NPHASE) { if (F.tid == 0) __hip_atomic_store(F.ctl + CW_TMO, 0xBADBA0u | (unsigned)(seam), RLX_AGENT); } \
    else { xcd_barrier(bar); } } while (0)
    unsigned char* ws = args.ws; F.ws = ws;
    F.ctl = (gu32*)(ws + WS_CTL);
    F.x = args.in[0]; F.g_ffn1_pre = args.in[1]; F.g_ffn1_post = args.in[2]; F.w1g = args.in[3]; F.w1u = args.in[4]; F.w1d = args.in[5];
    F.g_mix_pre = args.in[6]; F.w_in = args.in[7]; F.w_psb = args.in[8]; F.w_pret = args.in[9]; F.w_out = args.in[10]; F.g_mix_post = args.in[11];
    F.g_ffn2_pre = args.in[12]; F.g_ffn2_post = args.in[13]; F.w2g = args.in[14]; F.w2u = args.in[15]; F.w2d = args.in[16]; F.out = args.out;
    for (int u = F.tid; u < (LDS_BYTES - LDSCTL_OFF) / 4; u += NWAVES * 64) ((LAS unsigned*)(F.lds + LDSCTL_OFF))[u] = 0u;
    __syncthreads();
    XcdBarrier bar; bar.bar = (unsigned*)(F.ctl + CW_BAR); bar.x = 0; bar.st = nullptr;
    if (N_LAUNCHES != NPHASE) bar = xcd_barrier_post((unsigned*)(F.ctl + CW_BAR), F.MISC + 8);

    const int lo = args.ph_lo, hi = args.ph_hi;
#define IN(k) (lo <= (k) && (k) < hi)
#define BOTH(k) (IN(k) && IN((k) + 1))
    bf16* H = (bf16*)(ws + WS_H);
    bf16* ACT = (bf16*)(ws + WS_ACT);

    if (IN(0)) { p0_prologue(F); if (BOTH(0)) GRID_BAR(0); }
    if (IN(1)) { pg8::Gemm g{H, (const bf16*)(ws + WS_WGU), M, 2 * FF, D}; pg8::StaticOrder S; S.init(M, 2 * FF, F.G, (int)blockIdx.x);
        pg8::EpiSwiGLU E{ACT, FF};
        pg8::gemm_phase<pg8::EpiSwiGLU, pg8::StaticOrder, true, true>(F.lds + RING_OFF, g, S, E);
        if (BOTH(1)) GRID_BAR(1); }
    if (IN(2)) { pg8::Gemm g{ACT, (const bf16*)(ws + WS_WD), M, D, FF}; pg8::StaticOrder S; S.init(M, D, F.G, (int)blockIdx.x);
        pg8::EpiF32 E{F.out, D};
        pg8::gemm_phase<pg8::EpiF32, pg8::StaticOrder, true, true>(F.lds + RING_OFF, g, S, E);
        if (BOTH(2)) GRID_BAR(2); }
    if (IN(3)) { rows_phase(F, F.out, F.x, F.out, F.g_ffn1_post, 0.5f, F.g_mix_pre, H);
        convert_ffn_weights(F, F.w2g, F.w2u, F.w2d, (LAS float*)(F.lds + RING_OFF + F.wave * 16384));
        if (BOTH(3)) GRID_BAR(3); }
    if (IN(4)) { pg8::Gemm g{H, (const bf16*)(ws + WS_WIN), M, NPROJ, D}; pg8::StaticOrder S; S.init(M, NPROJ, F.G, (int)blockIdx.x);
        pg8::EpiProj E{(bf16*)(ws + WS_QKVS), (bf16*)(ws + WS_RET), (bf16*)(ws + WS_GATES), (const float*)(ws + WS_ROPE), (const float*)(ws + WS_ROPE) + 2048 * 64};
        pg8::gemm_phase<pg8::EpiProj, pg8::StaticOrder, true, true>(F.lds + RING_OFF, g, S, E);
        if (BOTH(4)) GRID_BAR(4); }
    if (IN(5)) { attn_naive(F); ret_naive(F); if (BOTH(5)) GRID_BAR(5); }
    if (IN(6)) { pg8::Gemm g{H, (const bf16*)(ws + WS_WP), M, 2 * D, D}; pg8::StaticOrder S; S.init(M, 2 * D, F.G, (int)blockIdx.x);
        pg8::EpiMerge E{(bf16*)(ws + WS_MERGED), (const bf16*)(ws + WS_GATES)};
        pg8::gemm_phase<pg8::EpiMerge, pg8::StaticOrder, true, true>(F.lds + RING_OFF, g, S, E);
        if (BOTH(6)) GRID_BAR(6); }
    if (IN(7)) { pg8::Gemm g{(const bf16*)(ws + WS_MERGED), (const bf16*)(ws + WS_WOUT), M, D, D}; pg8::StaticOrder S; S.init(M, D, F.G, (int)blockIdx.x);
        pg8::EpiF32 E{(float*)(ws + WS_Z), D};
        pg8::gemm_phase<pg8::EpiF32, pg8::StaticOrder, true, true>(F.lds + RING_OFF, g, S, E);
        if (BOTH(7)) GRID_BAR(7); }
    if (IN(8)) { rows_phase(F, (const float*)(ws + WS_Z), F.out, F.out, F.g_mix_post, 1.0f, F.g_ffn2_pre, H); if (BOTH(8)) GRID_BAR(8); }
    if (IN(9)) { pg8::Gemm g{H, (const bf16*)(ws + WS_WGU), M, 2 * FF, D}; pg8::StaticOrder S; S.init(M, 2 * FF, F.G, (int)blockIdx.x);
        pg8::EpiSwiGLU E{ACT, FF};
        pg8::gemm_phase<pg8::EpiSwiGLU, pg8::StaticOrder, true, true>(F.lds + RING_OFF, g, S, E);
        if (BOTH(9)) GRID_BAR(9); }
    if (IN(10)) { pg8::Gemm g{ACT, (const bf16*)(ws + WS_WD), M, D, FF}; pg8::StaticOrder S; S.init(M, D, F.G, (int)blockIdx.x);
        pg8::EpiF32 E{(float*)(ws + WS_Y2), D};
        pg8::gemm_phase<pg8::EpiF32, pg8::StaticOrder, true, true>(F.lds + RING_OFF, g, S, E);
        if (BOTH(10)) GRID_BAR(10); }
    if (IN(11)) { rows_phase(F, (const float*)(ws + WS_Y2), F.out, F.out, F.g_ffn2_post, 0.5f, nullptr, nullptr); }
#undef IN
#undef BOTH
}

extern "C" void kernel_launch(void* const* d_in, const int* in_sizes, int n_in, void* d_out, int out_size, void* d_ws, size_t ws_size, hipStream_t stream) {
    static int grid = 0;
    if (grid == 0) {
        if (n_in != 17 || in_sizes[0] != M * D || out_size != M * D || ws_size < WS_END) { fprintf(stderr, "kernel_launch: unexpected shapes: n_in %d in0 %d out %d ws %zu (need %zu)\n", n_in, n_in > 0 ? in_sizes[0] : -1, out_size, ws_size, (size_t)WS_END); grid = -1; return; }
        int dev = 0, cus = 0, per_cu = 0;
        if (hipGetDevice(&dev) != hipSuccess || hipDeviceGetAttribute(&cus, hipDeviceAttributeMultiprocessorCount, dev) != hipSuccess) { fprintf(stderr, "kernel_launch: device query failed\n"); grid = -1; return; }
        if (hipFuncSetAttribute((const void*)skel_fwd, hipFuncAttributeMaxDynamicSharedMemorySize, LDS_BYTES) != hipSuccess) { fprintf(stderr, "kernel_launch: hipFuncSetAttribute failed\n"); grid = -1; return; }
        if (hipOccupancyMaxActiveBlocksPerMultiprocessor(&per_cu, (const void*)skel_fwd, NWAVES * 64, LDS_BYTES) != hipSuccess || per_cu < 1)
            fprintf(stderr, "kernel_launch: note: occupancy query reports %d workgroups per CU\n", per_cu);
        (void)hipGetLastError();
        grid = cus;
        if (grid > 256) grid = 256;
    }
    if (grid < 0) return;
    if (hipMemsetAsync((char*)d_ws + WS_CTL, 0, CTL_ZERO_BYTES, stream) != hipSuccess) { fprintf(stderr, "kernel_launch: memset failed\n"); return; }
    Args a{};
    for (int i = 0; i < 17; ++i) a.in[i] = (const float*)d_in[i];
    a.out = (float*)d_out; a.ws = (unsigned char*)d_ws;
    for (int li = 0; li < N_LAUNCHES; ++li) {
        a.ph_lo = (N_LAUNCHES == NPHASE) ? li : 0; a.ph_hi = (N_LAUNCHES == NPHASE) ? li + 1 : NPHASE; a.li = li;
        hipLaunchKernelGGL(skel_fwd, dim3(grid), dim3(NWAVES * 64), LDS_BYTES, stream, a);
        const hipError_t le = hipPeekAtLastError();
        if (le != hipSuccess) { fprintf(stderr, "kernel_launch: launch %d failed: %s\n", li, hipGetErrorName(le)); break; }
    }
}
```

```cpp
#include <hip/hip_runtime.h>
#include <cstdio>
#include <cstdint>
#include <cmath>
namespace pg8 {
#define PG8_LAS __attribute__((address_space(3)))
typedef unsigned short bf16_t;
typedef short bf16x8 __attribute__((ext_vector_type(8)));
typedef float f32x4 __attribute__((ext_vector_type(4)));
typedef unsigned u32x4 __attribute__((ext_vector_type(4)));
constexpr int BM = 256, BK = 64, HALF = 128, HTB = HALF * BK * 2  , STAGE_BYTES = 8 * HTB, NXCD = 8, WGM = 8;

__host__ __device__ __forceinline__ int lds_byte(int r, int c) { const int st = (r >> 4) * 2 + (c >> 5), rr = r & 15, cc = c & 31, ob = rr * 64 + cc * 2; return st * 1024 + (ob ^ (((ob >> 9) & 1) << 5)); }
__host__ __device__ __forceinline__ void stage_rc(int b, int& R, int& C) { const int st = b / 1024, sb = b % 1024, swz = sb ^ (((sb >> 9) & 1) << 5); R = (st >> 1) * 16 + swz / 64; C = (st & 1) * 32 + (swz % 64) / 2; }
__host__ __device__ __forceinline__ int perm32(int rho) { const int n = rho >> 4, i = rho & 15; return 8 * (i >> 2) + 4 * n + (i & 3); }

struct Unit { int pm, pn; };
struct Gemm { const bf16_t* A; const bf16_t* Bt; int M, N, K; };

struct StaticOrder {
    int nM, nN, nwg, G, c;
    __host__ __device__ void init(int M, int N, int G_, int c_) { nM = M / BM; nN = N / BM; nwg = nM * nN; G = G_; c = c_; }
    __host__ __device__ bool next(int i, Unit& u) const {
        const long L = (long)i * G + c; if (L >= nwg) return false;
        int wgid = (int)L; { const int q = nwg / NXCD, r = nwg % NXCD, xcd = wgid % NXCD, off = wgid / NXCD; wgid = (xcd < r ? xcd * (q + 1) : r * (q + 1) + (xcd - r) * q) + off; }
        const int nig = WGM * nN, gid = wgid / nig, fm = gid * WGM, gsz = (nM - fm) < WGM ? (nM - fm) : WGM;
        u.pm = fm + ((wgid % nig) % gsz); u.pn = (wgid % nig) / gsz; return true;
    }
    __device__ __forceinline__ void a_ready(const Unit&) const {}
    __device__ __forceinline__ void done(const Unit&) const {}
};

__device__ __forceinline__ unsigned cvt_pk_bf16(float lo, float hi) { unsigned r; asm volatile("v_cvt_pk_bf16_f32 %0, %1, %2" : "=v"(r) : "v"(lo), "v"(hi)); return r; }
typedef float f32x2 __attribute__((ext_vector_type(2)));

__device__ __forceinline__ float fast_sigmoid(float x) { return __builtin_amdgcn_rcpf(1.0f + __expf(-x)); }
__device__ __forceinline__ float bf_lo(unsigned w) { return __uint_as_float(w << 16); }
__device__ __forceinline__ float bf_hi(unsigned w) { return __uint_as_float(w & 0xffff0000u); }

struct EpiSwiGLU {
    static constexpr bool PERM = true, AFTER_DRAIN = false;
    bf16_t* O; int ldc;
    __device__ __forceinline__ void operator()(const f32x4 (&acc)[2][2][4][2], const Unit& u, int wr, int wc, int fr, int fq) const {
        const int row0 = u.pm * BM + wr * 64 + fr, col0 = u.pn * HALF + wc * 32 + 8 * fq;
#pragma unroll
        for (int ai = 0; ai < 2; ++ai)
#pragma unroll
            for (int m = 0; m < 4; ++m) {
                bf16_t* rowp = O + (size_t)(row0 + ai * HALF + m * 16) * ldc + col0;
                float v[8];
#pragma unroll
                for (int n = 0; n < 2; ++n)
#pragma unroll
                    for (int e = 0; e < 4; ++e) { const float g = acc[ai][0][m][n][e], up = acc[ai][1][m][n][e]; v[4 * n + e] = g * fast_sigmoid(g) * up; }
                u32x4 w; w.x = cvt_pk_bf16(v[0], v[1]); w.y = cvt_pk_bf16(v[2], v[3]); w.z = cvt_pk_bf16(v[4], v[5]); w.w = cvt_pk_bf16(v[6], v[7]);
                *(u32x4*)rowp = w;
            }
    }
};

struct EpiF32 {
    static constexpr bool PERM = false, AFTER_DRAIN = false;
    float* O; int ldc;
    __device__ __forceinline__ void operator()(const f32x4 (&acc)[2][2][4][2], const Unit& u, int wr, int wc, int fr, int fq) const {
        const int row0 = u.pm * BM + wr * 64 + fr, col0 = u.pn * BM + wc * 32 + 4 * fq;
#pragma unroll
        for (int ai = 0; ai < 2; ++ai)
#pragma unroll
            for (int m = 0; m < 4; ++m) {
                float* rowp = O + (size_t)(row0 + ai * HALF + m * 16) * ldc + col0;
#pragma unroll
                for (int bj = 0; bj < 2; ++bj)
#pragma unroll
                    for (int n = 0; n < 2; ++n) *(f32x4*)(rowp + bj * HALF + n * 16) = acc[ai][bj][m][n];
            }
    }
};

struct EpiProj {
    static constexpr bool PERM = true, AFTER_DRAIN = false;
    bf16_t* QKVS; bf16_t* RET; bf16_t* GATES; const float* ropec; const float* ropes;
    __device__ __forceinline__ void operator()(const f32x4 (&acc)[2][2][4][2], const Unit& u, int wr, int wc, int fr, int fq) const {
        const int row0 = u.pm * BM + wr * 64 + fr; const int pn = u.pn;
        if (pn >= 6 && pn < 10) {
            const float sc = (pn >= 8) ? 0.08838834764831845f : 1.0f;
            const int hl = wc >> 1, i0 = 32 * (wc & 1) + 8 * fq;
            const int colb = (pn - 6) * BM + hl * 128 + i0;
#pragma unroll
            for (int ai = 0; ai < 2; ++ai)
#pragma unroll
                for (int m = 0; m < 4; ++m) {
                    const int row = row0 + ai * HALF + m * 16; const int pos = row & 2047;
                    const f32x4 c0 = *(const f32x4*)(ropec + pos * 64 + i0), c1 = *(const f32x4*)(ropec + pos * 64 + i0 + 4);
                    const f32x4 s0 = *(const f32x4*)(ropes + pos * 64 + i0), s1 = *(const f32x4*)(ropes + pos * 64 + i0 + 4);
                    float o1[8], o2[8];
#pragma unroll
                    for (int n = 0; n < 2; ++n)
#pragma unroll
                        for (int e = 0; e < 4; ++e) { const float x1 = acc[ai][0][m][n][e], x2 = acc[ai][1][m][n][e]; const float c = n ? c1[e] : c0[e], s = n ? s1[e] : s0[e];
                            o1[4 * n + e] = (x1 * c - x2 * s) * sc; o2[4 * n + e] = (x1 * s + x2 * c) * sc; }
                    bf16_t* rowp = RET + (size_t)row * 2048 + colb;
                    u32x4 w; w.x = cvt_pk_bf16(o1[0], o1[1]); w.y = cvt_pk_bf16(o1[2], o1[3]); w.z = cvt_pk_bf16(o1[4], o1[5]); w.w = cvt_pk_bf16(o1[6], o1[7]);
                    *(u32x4*)rowp = w;
                    w.x = cvt_pk_bf16(o2[0], o2[1]); w.y = cvt_pk_bf16(o2[2], o2[3]); w.z = cvt_pk_bf16(o2[4], o2[5]); w.w = cvt_pk_bf16(o2[6], o2[7]);
                    *(u32x4*)(rowp + 64) = w;
                }
            return;
        }
        bf16_t* base; int ldc, colt; float sc = 1.0f;
        if (pn < 6) { base = QKVS; ldc = 1536; colt = pn * BM; if (pn < 2) sc = 0.125f; }
        else if (pn < 14) { base = RET; ldc = 2048; colt = (pn - 6) * BM; }
        else { base = GATES; ldc = 2048; colt = (pn - 14) * BM; }
        const int col0 = colt + wc * 32 + 8 * fq;
#pragma unroll
        for (int ai = 0; ai < 2; ++ai)
#pragma unroll
            for (int m = 0; m < 4; ++m) { bf16_t* rowp = base + (size_t)(row0 + ai * HALF + m * 16) * ldc + col0;
#pragma unroll
                for (int bj = 0; bj < 2; ++bj) { const f32x4 v0 = acc[ai][bj][m][0] * sc, v1 = acc[ai][bj][m][1] * sc;
                    u32x4 w; w.x = cvt_pk_bf16(v0[0], v0[1]); w.y = cvt_pk_bf16(v0[2], v0[3]); w.z = cvt_pk_bf16(v1[0], v1[1]); w.w = cvt_pk_bf16(v1[2], v1[3]);
                    *(u32x4*)(rowp + bj * HALF) = w; } }
    }
};

struct EpiMerge {
    static constexpr bool PERM = true, AFTER_DRAIN = false;
    bf16_t* O; const bf16_t* GATES;
    __device__ __forceinline__ void operator()(const f32x4 (&acc)[2][2][4][2], const Unit& u, int wr, int wc, int fr, int fq) const {
        const int row0 = u.pm * BM + wr * 64 + fr, col0 = u.pn * HALF + wc * 32 + 8 * fq;
#pragma unroll
        for (int ai = 0; ai < 2; ++ai)
#pragma unroll
            for (int m = 0; m < 4; ++m) {
                const size_t row = (size_t)(row0 + ai * HALF + m * 16);
                const u32x4 ga = *(const u32x4*)(GATES + row * 2048 + col0), gb = *(const u32x4*)(GATES + row * 2048 + 1024 + col0);
                float a[8], b[8];
                a[0] = bf_lo(ga.x); a[1] = bf_hi(ga.x); a[2] = bf_lo(ga.y); a[3] = bf_hi(ga.y); a[4] = bf_lo(ga.z); a[5] = bf_hi(ga.z); a[6] = bf_lo(ga.w); a[7] = bf_hi(ga.w);
                b[0] = bf_lo(gb.x); b[1] = bf_hi(gb.x); b[2] = bf_lo(gb.y); b[3] = bf_hi(gb.y); b[4] = bf_lo(gb.z); b[5] = bf_hi(gb.z); b[6] = bf_lo(gb.w); b[7] = bf_hi(gb.w);
                float v[8];
#pragma unroll
                for (int n = 0; n < 2; ++n)
#pragma unroll
                    for (int e = 0; e < 4; ++e) v[4 * n + e] = fast_sigmoid(a[4 * n + e]) * acc[ai][0][m][n][e] + fast_sigmoid(b[4 * n + e]) * acc[ai][1][m][n][e];
                u32x4 w; w.x = cvt_pk_bf16(v[0], v[1]); w.y = cvt_pk_bf16(v[2], v[3]); w.z = cvt_pk_bf16(v[4], v[5]); w.w = cvt_pk_bf16(v[6], v[7]);
                *(u32x4*)(O + row * 1024 + col0) = w;
            }
    }
};
template <class Epi, class Sched, bool ALIGN_EPI = false, bool SP2 = false>
__device__ __forceinline__ void gemm_phase(PG8_LAS unsigned char* lds, const Gemm g, const Sched& S, const Epi& E) {
    const int tid = threadIdx.x, wid = __builtin_amdgcn_readfirstlane(tid >> 6), lane = tid & 63, wr = wid >> 2, wc = wid & 3, fr = lane & 15, fq = lane >> 4;
    const int K = g.K, nt = K / BK;
    unsigned voffA[2], voffB[2];
#pragma unroll
    for (int i = 0; i < 2; ++i) { int R, C; stage_rc(tid * 16 + i * 8192, R, C); const int Rb = Epi::PERM ? ((R & ~31) + perm32(R & 31)) : R;
        voffA[i] = (unsigned)(R * K + C) * 2u; voffB[i] = (unsigned)(Rb * K + C) * 2u; }
    const size_t kstep = (size_t)(BK * 2);
    const size_t hstep = (size_t)HALF * K * 2;
    const size_t tstep = 2 * hstep;
    const unsigned ldsw = (unsigned)wid * 1024u;
    const int aoff = lds_byte(wr * 64 + fr, fq * 8), boff = lds_byte(wc * 32 + fr, fq * 8);
#define PG8_SA(b, h) (((b) * 2 + (h)) * HTB)
#define PG8_SB(b, h) ((4 + (b) * 2 + (h)) * HTB)
#define PG8_STAGE(bufoff, gbase, voff) do { _Pragma("unroll") for (int _i = 0; _i < 2; ++_i) \
        __builtin_amdgcn_global_load_lds((const unsigned*)((const char*)(gbase) + (voff)[_i]), (PG8_LAS unsigned*)(lds + (bufoff) + ldsw + _i * 8192), 16, 0, 0); } while (0)
#define PG8_LDA(dst, b, h) do { _Pragma("unroll") for (int m = 0; m < 4; ++m) _Pragma("unroll") for (int k = 0; k < 2; ++k) dst[m][k] = *(const PG8_LAS bf16x8*)(lds + PG8_SA(b, h) + aoff + m * 2048 + k * 1024); } while (0)
#define PG8_LDB(dst, b, h) do { _Pragma("unroll") for (int n = 0; n < 2; ++n) _Pragma("unroll") for (int k = 0; k < 2; ++k) dst[n][k] = *(const PG8_LAS bf16x8*)(lds + PG8_SB(b, h) + boff + n * 2048 + k * 1024); } while (0)
#define PG8_MMA(ai, bj, At, Bt) do { __builtin_amdgcn_s_setprio(1); _Pragma("unroll") for (int m = 0; m < 4; ++m) _Pragma("unroll") for (int n = 0; n < 2; ++n) _Pragma("unroll") for (int k = 0; k < 2; ++k) \
        acc[ai][bj][m][n] = __builtin_amdgcn_mfma_f32_16x16x32_bf16(Bt[n][k], At[m][k], acc[ai][bj][m][n], 0, 0, 0); __builtin_amdgcn_s_setprio(0); } while (0)
#define PG8_WAIT_V(n) asm volatile("s_waitcnt vmcnt(" #n ")" ::: "memory")
#define PG8_WAIT_L(n) asm volatile("s_waitcnt lgkmcnt(" #n ")" ::: "memory")
#define PG8_BAR __builtin_amdgcn_s_barrier()
#define PG8_SCHED __builtin_amdgcn_sched_barrier(0)
    Unit cur, nxt; int ui = 0;
    if (!S.next(0, cur)) return;
    f32x4 acc[2][2][4][2];
#pragma unroll
    for (int a = 0; a < 2; ++a)
#pragma unroll
        for (int b = 0; b < 2; ++b)
#pragma unroll
            for (int m = 0; m < 4; ++m)
#pragma unroll
                for (int n = 0; n < 2; ++n) acc[a][b][m][n] = (f32x4){0.f, 0.f, 0.f, 0.f};
    bf16x8 At[4][2], B0[2][2], B1[2][2];
    const char* cA = (const char*)g.A + (size_t)cur.pm * tstep; const char* cB = (const char*)g.Bt + (size_t)cur.pn * tstep;
    S.a_ready(cur);
    if constexpr (SP2) {
        PG8_STAGE(PG8_SB(0, 0), cB, voffB); PG8_STAGE(PG8_SB(0, 1), cB + hstep, voffB); PG8_STAGE(PG8_SA(0, 0), cA, voffA); PG8_STAGE(PG8_SA(0, 1), cA + hstep, voffA);
        if (wr == 1) PG8_BAR;
        PG8_WAIT_V(2); PG8_BAR;
        PG8_STAGE(PG8_SB(1, 0), cB + kstep, voffB); PG8_STAGE(PG8_SA(1, 0), cA + kstep, voffA); PG8_STAGE(PG8_SB(1, 1), cB + hstep + kstep, voffB);
        PG8_WAIT_V(6); PG8_BAR;
    } else {
        PG8_STAGE(PG8_SB(0, 0), cB, voffB); PG8_STAGE(PG8_SA(0, 0), cA, voffA); PG8_STAGE(PG8_SB(0, 1), cB + hstep, voffB); PG8_STAGE(PG8_SA(0, 1), cA + hstep, voffA);
        if (wr == 1) PG8_BAR;
        PG8_WAIT_V(4); PG8_BAR;
        PG8_STAGE(PG8_SB(1, 0), cB + kstep, voffB); PG8_STAGE(PG8_SA(1, 0), cA + kstep, voffA); PG8_STAGE(PG8_SB(1, 1), cB + hstep + kstep, voffB);
        PG8_WAIT_V(6); PG8_BAR;
    }
    for (;;) {
        const bool has_next = S.next(ui + 1, nxt);
        const char* nA = has_next ? (const char*)g.A + (size_t)nxt.pm * tstep : cA; const char* nB = has_next ? (const char*)g.Bt + (size_t)nxt.pn * tstep : cB;
        for (int t = 0; t < nt; t += 2) {
            const bool last = (t == nt - 2);
            const char* a1 = cA + (size_t)(t + 1) * kstep;
            const char* a2 = last ? nA : cA + (size_t)(t + 2) * kstep; const char* b2 = last ? nB : cB + (size_t)(t + 2) * kstep;
            const char* a3 = a2 + kstep; const char* b3 = b2 + kstep;
            if (last && has_next) S.a_ready(nxt);
            if constexpr (SP2) {
            PG8_LDB(B0, 0, 0); PG8_LDB(B1, 0, 1); PG8_SCHED; PG8_LDA(At, 0, 0); PG8_STAGE(PG8_SA(1, 1), a1 + hstep, voffA);
            PG8_WAIT_V(8); PG8_WAIT_L(0); PG8_BAR; PG8_MMA(0, 0, At, B0); PG8_MMA(0, 1, At, B1); PG8_BAR; PG8_SCHED;
            PG8_LDA(At, 0, 1); PG8_STAGE(PG8_SB(0, 0), b2, voffB); PG8_STAGE(PG8_SB(0, 1), b2 + hstep, voffB); PG8_STAGE(PG8_SA(0, 0), a2, voffA);
            PG8_WAIT_V(8); PG8_WAIT_L(0); PG8_BAR; PG8_MMA(1, 0, At, B0); PG8_MMA(1, 1, At, B1); PG8_BAR; PG8_SCHED;
            PG8_LDB(B0, 1, 0); PG8_LDB(B1, 1, 1); PG8_SCHED; PG8_LDA(At, 1, 0); PG8_STAGE(PG8_SA(0, 1), a2 + hstep, voffA);
            PG8_WAIT_V(8); PG8_WAIT_L(0); PG8_BAR; PG8_MMA(0, 0, At, B0); PG8_MMA(0, 1, At, B1); PG8_BAR; PG8_SCHED;
            PG8_LDA(At, 1, 1); PG8_STAGE(PG8_SB(1, 0), b3, voffB); PG8_STAGE(PG8_SB(1, 1), b3 + hstep, voffB); PG8_STAGE(PG8_SA(1, 0), a3, voffA);
            PG8_WAIT_V(8); PG8_WAIT_L(0); PG8_BAR; PG8_MMA(1, 0, At, B0); PG8_MMA(1, 1, At, B1); PG8_BAR; PG8_SCHED;
            } else {
            PG8_LDB(B0, 0, 0); PG8_SCHED; PG8_LDA(At, 0, 0); PG8_STAGE(PG8_SA(1, 1), a1 + hstep, voffA);
            PG8_WAIT_L(8); PG8_BAR; PG8_WAIT_L(0); PG8_MMA(0, 0, At, B0); PG8_BAR; PG8_SCHED;
            PG8_LDB(B1, 0, 1); PG8_STAGE(PG8_SB(0, 0), b2, voffB);
            PG8_BAR; PG8_WAIT_L(0); PG8_MMA(0, 1, At, B1); PG8_BAR;
            PG8_LDA(At, 0, 1); PG8_STAGE(PG8_SA(0, 0), a2, voffA);
            PG8_BAR; PG8_WAIT_L(0); PG8_MMA(1, 0, At, B0); PG8_BAR; PG8_SCHED;
            PG8_STAGE(PG8_SB(0, 1), b2 + hstep, voffB);
            PG8_WAIT_V(6); PG8_BAR; PG8_MMA(1, 1, At, B1); PG8_BAR;
            PG8_LDB(B0, 1, 0); PG8_SCHED; PG8_LDA(At, 1, 0); PG8_STAGE(PG8_SA(0, 1), a2 + hstep, voffA);
            PG8_WAIT_L(8); PG8_BAR; PG8_WAIT_L(0); PG8_MMA(0, 0, At, B0); PG8_BAR; PG8_SCHED;
            PG8_LDB(B1, 1, 1); PG8_STAGE(PG8_SB(1, 0), b3, voffB);
            PG8_BAR; PG8_WAIT_L(0); PG8_MMA(0, 1, At, B1); PG8_BAR;
            PG8_LDA(At, 1, 1); PG8_STAGE(PG8_SA(1, 0), a3, voffA);
            PG8_BAR; PG8_WAIT_L(0); PG8_MMA(1, 0, At, B0); PG8_BAR; PG8_SCHED;
            PG8_STAGE(PG8_SB(1, 1), b3 + hstep, voffB);
            PG8_WAIT_V(6); PG8_BAR; PG8_MMA(1, 1, At, B1); PG8_BAR;
            }
        }
        if constexpr (ALIGN_EPI) { if (wr == 0) PG8_BAR; }
        if constexpr (!Epi::AFTER_DRAIN) { E(acc, cur, wr, wc, fr, fq); S.done(cur); }
        if (!has_next) break;
#pragma unroll
        for (int a = 0; a < 2; ++a)
#pragma unroll
            for (int b = 0; b < 2; ++b)
#pragma unroll
                for (int m = 0; m < 4; ++m)
#pragma unroll
                    for (int n = 0; n < 2; ++n) acc[a][b][m][n] = (f32x4){0.f, 0.f, 0.f, 0.f};
        cur = nxt; cA = nA; cB = nB; ++ui;
        if constexpr (ALIGN_EPI) { if (wr == 1) PG8_BAR; }
    }
    PG8_WAIT_V(0);
    if constexpr (!ALIGN_EPI) { if (wr == 0) PG8_BAR; }
    PG8_BAR;
    if constexpr (Epi::AFTER_DRAIN) { E.fused(acc, cur, wr, wc, fr, fq, lds, wid, lane); S.done(cur); }
#undef PG8_SA
#undef PG8_SB
#undef PG8_STAGE
#undef PG8_LDA
#undef PG8_LDB
#undef PG8_MMA
#undef PG8_WAIT_V
#undef PG8_WAIT_L
#undef PG8_BAR
#undef PG8_SCHED
}
}
#define GAS __attribute__((address_space(1)))
#define LAS __attribute__((address_space(3)))
typedef unsigned short bf16;
typedef unsigned v4u __attribute__((ext_vector_type(4)));
typedef float f32x4 __attribute__((ext_vector_type(4)));
typedef short bf16x8 __attribute__((ext_vector_type(8)));
typedef GAS unsigned gu32;
typedef GAS unsigned long long gu64;
#define RLX_AGENT __ATOMIC_RELAXED, __HIP_MEMORY_SCOPE_AGENT
#define LDS_WAIT() asm volatile("s_waitcnt lgkmcnt(0)" ::: "memory")
#define VM_WAIT() asm volatile("s_waitcnt vmcnt(0)" ::: "memory")
__device__ __forceinline__ unsigned long long rt() { return __builtin_amdgcn_s_memrealtime(); }
__device__ __forceinline__ unsigned f2bf(float f) { unsigned u = __builtin_bit_cast(unsigned, f); return (u + 0x7fffu + ((u >> 16) & 1u)) >> 16; }
__device__ __forceinline__ unsigned pk2(float lo, float hi) { return f2bf(lo) | (f2bf(hi) << 16); }

#define XB_TMO      128
#define XB_XCNT(j)  (256  + 64 * (j))
#define XB_XSUB(j)  (1280 + 64 * (j))
#define XB_XGEN(j)  (2304 + 64 * (j))
#define XB_TOP      3328
#define XB_TOPGEN   3392
#define XCD_BAR_WORDS 3456
#define XB_SPIN_CAP (1u << 18)

__device__ __forceinline__ unsigned xb_ld(unsigned* p)              { return __hip_atomic_load(p, __ATOMIC_RELAXED, __HIP_MEMORY_SCOPE_AGENT); }
__device__ __forceinline__ unsigned xb_add(unsigned* p, unsigned v) { return __hip_atomic_fetch_add(p, v, __ATOMIC_RELAXED, __HIP_MEMORY_SCOPE_AGENT); }
__device__ __forceinline__ unsigned xb_xcc_id() { return (unsigned)__builtin_amdgcn_s_getreg((3 << 11) | 20) & 0xFu; }
#define XB_SPIN(cond, bar) do { unsigned _sp = 0; while (cond) { __builtin_amdgcn_s_sleep(1); \
    if ((++_sp & 255u) == 0u) { if (xb_ld(&(bar)[XB_TMO])) break; if (_sp > XB_SPIN_CAP) { atomicAdd(&(bar)[XB_TMO], 1u); break; } } } } while (0)

struct XcdBarrier {
    unsigned* bar; unsigned x;
    volatile LAS unsigned* st;
};

__device__ __forceinline__ XcdBarrier xcd_barrier_post(unsigned* bar, volatile LAS unsigned* st) {
    XcdBarrier b; b.bar = bar; b.x = xb_xcc_id(); b.st = st;
    if (threadIdx.x == 0) (void)xb_add(&bar[XB_XCNT(b.x)], 1u);
    return b;
}
__device__ __forceinline__ void xcd_barrier_complete(unsigned* bar, unsigned x, unsigned& nloc, unsigned& nx) {
    const unsigned G = gridDim.x * gridDim.y * gridDim.z;
    unsigned sum, cnt, mine, sp = 0u;
    for (;;) {
        sum = 0u; cnt = 0u; mine = 0u;
#pragma unroll
        for (unsigned j = 0; j < 16; ++j) { const unsigned c = xb_ld(&bar[XB_XCNT(j)]); sum += c; cnt += (c > 0u) ? 1u : 0u; mine = (j == x) ? c : mine; }
        if (sum == G) break;
        __builtin_amdgcn_s_sleep(1);
        if ((++sp & 255u) == 0u) { if (xb_ld(&bar[XB_TMO])) break; if (sp > XB_SPIN_CAP) { atomicAdd(&bar[XB_TMO], 1u); break; } }
    }
    nloc = mine > 0u ? mine : 1u; nx = cnt > 0u ? cnt : 1u;
}

__device__ __forceinline__ void xcd_barrier(const XcdBarrier& b) {
    asm volatile("s_waitcnt vmcnt(0)" ::: "memory");
    __syncthreads();
    if (threadIdx.x == 0) {
        unsigned* bar = b.bar;
        __builtin_amdgcn_s_waitcnt(0);
        unsigned nloc = b.st[0], nx = b.st[1];
        if (nloc == 0u) { xcd_barrier_complete(bar, b.x, nloc, nx); b.st[0] = nloc; b.st[1] = nx; }
        const unsigned old = xb_add(&bar[XB_XSUB(b.x)], 1u);
        const unsigned gen = old / nloc;
        if (old + 1u == (gen + 1u) * nloc) {
            __builtin_amdgcn_fence(__ATOMIC_RELEASE, "agent");
            asm volatile("s_waitcnt vmcnt(0)" ::: "memory");
            const unsigned og = xb_add(&bar[XB_TOP], 1u);
            const unsigned tg = og / nx;
            if (og + 1u == (tg + 1u) * nx) xb_add(&bar[XB_TOPGEN], 1u);
            else XB_SPIN(xb_ld(&bar[XB_TOPGEN]) == tg, bar);
            __builtin_amdgcn_fence(__ATOMIC_ACQUIRE, "agent");
            xb_add(&bar[XB_XGEN(b.x)], 1u);
            asm volatile("s_waitcnt vmcnt(0)" ::: "memory");
        } else {
            XB_SPIN(xb_ld(&bar[XB_XGEN(b.x)]) == gen, bar);
            __builtin_amdgcn_fence(__ATOMIC_ACQUIRE, "agent");
            asm volatile("s_waitcnt vmcnt(0)" ::: "memory");
        }
    }
    __syncthreads();
}

constexpr int NWAVES = 8;
#ifndef MK_N_LAUNCHES
#define MK_N_LAUNCHES 1
#endif
constexpr int N_LAUNCHES = MK_N_LAUNCHES;
constexpr int NPHASE = 12;
constexpr int BATCH = 8, SEQ = 2048, D = 1024, FF = 4096, M = BATCH * SEQ;
constexpr int NPROJ = 5632;
constexpr float RMS_EPS = 1e-6f, GN_EPS = 1e-5f;

constexpr size_t MiB = 1u << 20;
constexpr size_t WS_CTL = 0, CTL_ZERO_BYTES = 1 * MiB;
constexpr size_t WS_ROPE = 1 * MiB;
constexpr size_t WS_WD = 2 * MiB;
constexpr size_t WS_H = 10 * MiB;
constexpr size_t WS_WIN = 42 * MiB;
constexpr size_t WS_WP = 53 * MiB;
constexpr size_t WS_WOUT = 57 * MiB;
constexpr size_t WS_WGU = 59 * MiB;
constexpr size_t WS_Y2 = 10 * MiB;
constexpr size_t WS_BIG = 75 * MiB;
constexpr size_t WS_ACT = WS_BIG;
constexpr size_t WS_QKVS = WS_BIG;
constexpr size_t WS_RET = WS_BIG + 48 * MiB;
constexpr size_t WS_GATES = WS_BIG + 112 * MiB;
constexpr size_t WS_MERGED = WS_BIG;
constexpr size_t WS_Z = WS_BIG + 48 * MiB;
constexpr size_t WS_END = 251 * MiB;
static_assert(WS_Y2 + (size_t)M * D * 4 <= WS_BIG && WS_GATES + (size_t)M * 2048 * 2 <= WS_END && WS_WGU + (size_t)8192 * 1024 * 2 <= WS_BIG, "ws map");
constexpr int CW_TMO = 0, CW_CODE = 1;
constexpr int CW_BAR = 4096;

constexpr int RING_OFF = 0, RING_BYTES = 131072;
constexpr int LDSCTL_OFF = RING_BYTES, MISC_OFF = LDSCTL_OFF + 320;
constexpr int LDS_BYTES = 147456;

struct Frame {
    LAS unsigned char* lds;
    volatile LAS unsigned* MISC;
    gu32* ctl;
    int tid, lane, wave;
    int vcu, G;
    const float* x; float* out;
    const float *g_ffn1_pre, *g_ffn1_post, *w1g, *w1u, *w1d, *g_mix_pre, *w_in, *w_psb, *w_pret, *w_out, *g_mix_post, *g_ffn2_pre, *g_ffn2_post, *w2g, *w2u, *w2d;
    unsigned char* ws;
};

__device__ __forceinline__ float wave_sum(float v) {
#pragma unroll
    for (int o = 1; o < 64; o <<= 1) v += __shfl_xor(v, o);
    return v;
}

__device__ __forceinline__ void tr_block(const float* W, int ldw, int k0, int n0, bf16* WT, int ldt, int drow0, int dk0, LAS float* scr, int lane) {
#pragma unroll 8
    for (int i = 0; i < 32; ++i) { const int kk = 2 * i + (lane >> 5); scr[kk * 33 + (lane & 31)] = W[(size_t)(k0 + kk) * ldw + n0 + (lane & 31)]; }
    LDS_WAIT(); asm volatile("" ::: "memory");
    const int c = lane & 7;
#pragma unroll
    for (int j = 0; j < 4; ++j) { const int n = (lane >> 3) + 8 * j; const LAS float* s = scr + (8 * c) * 33 + n;
        v4u o; o.x = pk2(s[0 * 33], s[1 * 33]); o.y = pk2(s[2 * 33], s[3 * 33]); o.z = pk2(s[4 * 33], s[5 * 33]); o.w = pk2(s[6 * 33], s[7 * 33]);
        *(GAS v4u*)(WT + (size_t)(drow0 + n) * ldt + dk0 + 8 * c) = o; }
    LDS_WAIT(); asm volatile("" ::: "memory");
}
__device__ __forceinline__ void tr_job(int kind, const float* W, int K, int N, bf16* WT, int ldt, int item, LAS float* scr, int lane) {
    const int nblk = N / 32, kb = item / nblk, nb = item % nblk, k0 = 64 * kb, n0 = 32 * nb;
    int drow0 = n0, dk0 = k0;
    if (kind == 1) drow0 = 256 * (n0 >> 7) + (n0 & 127);
    else if (kind == 2) drow0 = 256 * (n0 >> 7) + 128 + (n0 & 127);
    else if (kind == 3) { const int tile = n0 >> 8; if (tile >= 6 && tile < 10) { const int local = n0 & 255, hl = local >> 7, within = local & 127, half = within >> 6, i0 = within & 63; drow0 = 256 * tile + 128 * half + 64 * hl + i0; } }
    else if (kind == 4) drow0 = 256 * (n0 >> 7) + (n0 & 127);
    else if (kind == 5) { drow0 = 256 * (n0 >> 7) + 128 + (n0 & 127); dk0 = 512 + k0; }
    tr_block(W, N, k0, n0, WT, ldt, drow0, dk0, scr, lane);
}

__device__ __forceinline__ void rms_to_bf16(const f32x4 (&v)[4], const float* g, bf16* orow, int lane) {
    float s = 0.f;
#pragma unroll
    for (int j = 0; j < 4; ++j) s += (v[j].x * v[j].x + v[j].y * v[j].y) + (v[j].z * v[j].z + v[j].w * v[j].w);
    const float rs = 1.0f / sqrtf(wave_sum(s) * (1.f / D) + RMS_EPS);
    GAS unsigned long long* o8 = (GAS unsigned long long*)orow + lane;
#pragma unroll
    for (int j = 0; j < 4; ++j) { const f32x4 gg = ((const GAS f32x4*)g)[lane + 64 * j];
        o8[64 * j] = (unsigned long long)pk2(v[j].x * rs * gg.x, v[j].y * rs * gg.y) | ((unsigned long long)pk2(v[j].z * rs * gg.z, v[j].w * rs * gg.w) << 32); }
}
__device__ __forceinline__ void rows_phase(Frame& F, const float* Y, const float* xres, float* xo, const float* g_post, float coef, const float* g_pre, bf16* hn) {
    const int gw = F.vcu * NWAVES + F.wave, NGW = F.G * NWAVES;
    for (int m = gw; m < M; m += NGW) {
        const GAS f32x4* yr = (const GAS f32x4*)(Y + (size_t)m * D) + F.lane;
        const GAS f32x4* xr = (const GAS f32x4*)(xres + (size_t)m * D) + F.lane;
        f32x4 y[4], xv[4]; float s = 0.f;
#pragma unroll
        for (int j = 0; j < 4; ++j) { y[j] = yr[64 * j]; xv[j] = xr[64 * j]; s += (y[j].x * y[j].x + y[j].y * y[j].y) + (y[j].z * y[j].z + y[j].w * y[j].w); }
        const float rs = coef / sqrtf(wave_sum(s) * (1.f / D) + RMS_EPS);
        GAS f32x4* orow = (GAS f32x4*)(xo + (size_t)m * D) + F.lane;
#pragma unroll
        for (int j = 0; j < 4; ++j) { const f32x4 gg = ((const GAS f32x4*)g_post)[F.lane + 64 * j]; xv[j] = xv[j] + y[j] * gg * rs; orow[64 * j] = xv[j]; }
        if (hn) rms_to_bf16(xv, g_pre, hn + (size_t)m * D, F.lane);
    }
}

__device__ __forceinline__ void convert_ffn_weights(Frame& F, const float* wg, const float* wu, const float* wd, LAS float* scr) {
    const int gw = F.vcu * NWAVES + F.wave, NGW = F.G * NWAVES;
    bf16* WGU = (bf16*)(F.ws + WS_WGU); bf16* WD = (bf16*)(F.ws + WS_WD);
    constexpr int I_G = (D / 64) * (FF / 32), I_D = (FF / 64) * (D / 32);
    for (int it = gw; it < 2 * I_G + I_D; it += NGW) {
        int r = it;
        if (r < I_G) { tr_job(1, wg, D, FF, WGU, D, r, scr, F.lane); continue; } r -= I_G;
        if (r < I_G) { tr_job(2, wu, D, FF, WGU, D, r, scr, F.lane); continue; } r -= I_G;
        tr_job(0, wd, FF, D, WD, FF, r, scr, F.lane);
    }
}

__device__ __forceinline__ void p0_prologue(Frame& F) {
    LAS float* scr = (LAS float*)(F.lds + RING_OFF + F.wave * 16384);
    const int gw = F.vcu * NWAVES + F.wave, NGW = F.G * NWAVES;
    convert_ffn_weights(F, F.w1g, F.w1u, F.w1d, scr);
    bf16* WIN = (bf16*)(F.ws + WS_WIN); bf16* WP = (bf16*)(F.ws + WS_WP); bf16* WOUT = (bf16*)(F.ws + WS_WOUT);
    constexpr int I_IN = (D / 64) * (NPROJ / 32), I_P = (512 / 64) * (D / 32), I_O = (D / 64) * (D / 32);
    for (int it = gw; it < I_IN + 2 * I_P + I_O; it += NGW) {
        int r = it;
        if (r < I_IN) { tr_job(3, F.w_in, D, NPROJ, WIN, D, r, scr, F.lane); continue; } r -= I_IN;
        if (r < I_P) { tr_job(4, F.w_psb, 512, D, WP, D, r, scr, F.lane); continue; } r -= I_P;
        if (r < I_P) { tr_job(5, F.w_pret, 512, D, WP, D, r, scr, F.lane); continue; } r -= I_P;
        tr_job(0, F.w_out, D, D, WOUT, D, r, scr, F.lane);
    }
    for (int r = gw; r < 2048; r += NGW) { const int kz = ((r & 255) < 128) ? 512 : 0; *(GAS v4u*)(WP + (size_t)r * 1024 + kz + 8 * F.lane) = (v4u){0u, 0u, 0u, 0u}; }
    { float* ct = (float*)(F.ws + WS_ROPE); float* st = ct + 2048 * 64;
      for (int idx = (F.vcu * NWAVES + F.wave) * 64 + F.lane; idx < 2048 * 64; idx += F.G * NWAVES * 64) {
          const int pos = idx >> 6, i = idx & 63;
          const float inv_freq = exp2f(-(float)i * (13.287712379549449f / 64.0f));
          const float ang = (float)pos * inv_freq;
          const double a = (double)ang; const double k = __builtin_rint(a * 0.15915494309189535);
          const double r = __builtin_fma(-k, 6.283185307179586, a) - k * 2.4492935982947064e-16;
          const float rf = (float)r; ct[idx] = cosf(rf); st[idx] = sinf(rf); } }
    bf16* H = (bf16*)(F.ws + WS_H);
    for (int m = gw; m < M; m += NGW) { const GAS f32x4* xr = (const GAS f32x4*)(F.x + (size_t)m * D) + F.lane; f32x4 v[4];
#pragma unroll
        for (int j = 0; j < 4; ++j) v[j] = xr[64 * j];
        rms_to_bf16(v, F.g_ffn1_pre, H + (size_t)m * D, F.lane); }
}

__device__ __forceinline__ void unpack8(const v4u w, float* f) {
    f[0] = __uint_as_float(w.x << 16); f[1] = __uint_as_float(w.x & 0xffff0000u); f[2] = __uint_as_float(w.y << 16); f[3] = __uint_as_float(w.y & 0xffff0000u);
    f[4] = __uint_as_float(w.z << 16); f[5] = __uint_as_float(w.z & 0xffff0000u); f[6] = __uint_as_float(w.w << 16); f[7] = __uint_as_float(w.w & 0xffff0000u);
}
__device__ __forceinline__ float bf2f(bf16 v) { return __uint_as_float((unsigned)v << 16); }

__device__ __forceinline__ void attn_naive(Frame& F) {
    const bf16* QKVS = (const bf16*)(F.ws + WS_QKVS); bf16* O2 = (bf16*)(F.ws + WS_H);
    const int bx = blockIdx.x;
    for (int bh = bx >> 2; bh < 64; bh += (F.G >> 2)) {
        const int q4 = bx & 3, wv = F.wave;
        const int tb = wv < 4 ? q4 * 4 + wv : 31 - (q4 * 4 + (wv - 4));
        const int t = tb * 64 + F.lane, b = bh >> 3, h = bh & 7;
        const bf16* base = QKVS + (size_t)(b * SEQ) * 1536 + h * 64;
        float q[64], acc[64];
        { const GAS v4u* qp = (const GAS v4u*)(base + (size_t)t * 1536);
#pragma unroll
          for (int j = 0; j < 8; ++j) unpack8(qp[j], q + 8 * j); }
#pragma unroll
        for (int j = 0; j < 64; ++j) acc[j] = 0.f;
        float between = 0.f;
        for (int s = t - 1; s >= 0; --s) {
            const GAS v4u* kp = (const GAS v4u*)(base + (size_t)s * 1536 + 512);
            const GAS v4u* vp = (const GAS v4u*)(base + (size_t)s * 1536 + 1024);
            float z = 0.f;
#pragma unroll
            for (int j = 0; j < 8; ++j) { float kf[8]; unpack8(kp[j], kf);
#pragma unroll
                for (int e = 0; e < 8; ++e) z += q[8 * j + e] * kf[e]; }
            const float lk = -(fmaxf(z, 0.f) + __logf(1.0f + __expf(-fabsf(z))));
            const float w = __expf(z + lk + between);
#pragma unroll
            for (int j = 0; j < 8; ++j) { float vf[8]; unpack8(vp[j], vf);
#pragma unroll
                for (int e = 0; e < 8; ++e) acc[8 * j + e] += w * vf[e]; }
            between += lk;
        }
        GAS v4u* op = (GAS v4u*)(O2 + (size_t)(b * SEQ + t) * 1024 + h * 64);
#pragma unroll
        for (int j = 0; j < 8; ++j) { v4u w; w.x = pk2(acc[8 * j], acc[8 * j + 1]); w.y = pk2(acc[8 * j + 2], acc[8 * j + 3]); w.z = pk2(acc[8 * j + 4], acc[8 * j + 5]); w.w = pk2(acc[8 * j + 6], acc[8 * j + 7]); op[j] = w; }
    }
}

__device__ __forceinline__ void ret_naive(Frame& F) {
    const bf16* RET = (const bf16*)(F.ws + WS_RET); bf16* O2 = (bf16*)(F.ws + WS_H);
    LAS float* red = (LAS float*)(F.lds + RING_OFF);
    for (int bh = blockIdx.x; bh < 32; bh += F.G) {
        const int b = bh >> 2, h = bh & 3;
        const float gamma = 1.0f - exp2f(-5.0f - (float)h);
        const int e = F.tid & 127, dg = F.tid >> 7;
        float S[32];
#pragma unroll
        for (int i = 0; i < 32; ++i) S[i] = 0.f;
        for (int t0 = 0; t0 < SEQ; t0 += 8) {
#pragma unroll 1
            for (int j = 0; j < 8; ++j) {
                const bf16* row = RET + (size_t)(b * SEQ + t0 + j) * 2048;
                const float vv = bf2f(row[1024 + h * 128 + e]);
                const GAS v4u* qp = (const GAS v4u*)(row + h * 128 + 32 * dg);
                const GAS v4u* kp = (const GAS v4u*)(row + 512 + h * 128 + 32 * dg);
                float p = 0.f;
#pragma unroll
                for (int c = 0; c < 4; ++c) { float qf[8], kf[8]; unpack8(qp[c], qf); unpack8(kp[c], kf);
#pragma unroll
                    for (int i = 0; i < 8; ++i) { S[8 * c + i] = gamma * S[8 * c + i] + kf[i] * vv; p += qf[i] * S[8 * c + i]; } }
                red[(j * 4 + dg) * 128 + e] = p;
            }
            __syncthreads();
            { const int j = F.wave; const bf16* row = RET + (size_t)(b * SEQ + t0 + j) * 2048;
              const float o0 = (red[(j * 4 + 0) * 128 + F.lane] + red[(j * 4 + 1) * 128 + F.lane]) + (red[(j * 4 + 2) * 128 + F.lane] + red[(j * 4 + 3) * 128 + F.lane]);
              const float o1 = (red[(j * 4 + 0) * 128 + 64 + F.lane] + red[(j * 4 + 1) * 128 + 64 + F.lane]) + (red[(j * 4 + 2) * 128 + 64 + F.lane] + red[(j * 4 + 3) * 128 + 64 + F.lane]);
              const float mean = wave_sum(o0 + o1) * (1.f / 128.f); const float d0 = o0 - mean, d1 = o1 - mean;
              const float var = wave_sum(d0 * d0 + d1 * d1) * (1.f / 128.f); const float rstd = 1.0f / sqrtf(var + GN_EPS);
              const float g0 = bf2f(row[1536 + h * 128 + F.lane]), g1 = bf2f(row[1536 + h * 128 + 64 + F.lane]);
              bf16* orow = O2 + (size_t)(b * SEQ + t0 + j) * 1024 + 512 + h * 128;
              orow[F.lane] = (bf16)f2bf(d0 * rstd * g0 * pg8::fast_sigmoid(g0)); orow[64 + F.lane] = (bf16)f2bf(d1 * rstd * g1 * pg8::fast_sigmoid(g1)); }
            __syncthreads();
        }
    }
}

struct Args { const float* in[17]; float* out; unsigned char* ws; int ph_lo, ph_hi, li, pad; };
__global__ void __launch_bounds__(NWAVES * 64, 2) skel_fwd(Args args) {
    extern __shared__ __attribute__((aligned(16))) unsigned char lds[];
    Frame F;
    F.lds = (LAS unsigned char*)lds;
    F.MISC = (volatile LAS unsigned*)(F.lds + MISC_OFF);
    F.tid = threadIdx.x; F.lane = F.tid & 63; F.wave = __builtin_amdgcn_readfirstlane(F.tid >> 6);
    F.G = gridDim.x; { const int bx = blockIdx.x; F.vcu = (F.G % 8 == 0) ? (bx % 8) * (F.G / 8) + bx / 8 : bx; }
#define GRID_BAR(seam) do { if (N_LAUNCHES == NPHASE) { if (F.tid == 0) __hip_atomic_store(F.ctl + CW_TMO, 0xBADBA0u | (unsigned)(seam), RLX_AGENT); } \
    else { xcd_barrier(bar); } } while (0)
    unsigned char* ws = args.ws; F.ws = ws;
    F.ctl = (gu32*)(ws + WS_CTL);
    F.x = args.in[0]; F.g_ffn1_pre = args.in[1]; F.g_ffn1_post = args.in[2]; F.w1g = args.in[3]; F.w1u = args.in[4]; F.w1d = args.in[5];
    F.g_mix_pre = args.in[6]; F.w_in = args.in[7]; F.w_psb = args.in[8]; F.w_pret = args.in[9]; F.w_out = args.in[10]; F.g_mix_post = args.in[11];
    F.g_ffn2_pre = args.in[12]; F.g_ffn2_post = args.in[13]; F.w2g = args.in[14]; F.w2u = args.in[15]; F.w2d = args.in[16]; F.out = args.out;
    for (int u = F.tid; u < (LDS_BYTES - LDSCTL_OFF) / 4; u += NWAVES * 64) ((LAS unsigned*)(F.lds + LDSCTL_OFF))[u] = 0u;
    __syncthreads();
    XcdBarrier bar; bar.bar = (unsigned*)(F.ctl + CW_BAR); bar.x = 0; bar.st = nullptr;
    if (N_LAUNCHES != NPHASE) bar = xcd_barrier_post((unsigned*)(F.ctl + CW_BAR), F.MISC + 8);

    const int lo = args.ph_lo, hi = args.ph_hi;
#define IN(k) (lo <= (k) && (k) < hi)
#define BOTH(k) (IN(k) && IN((k) + 1))
    bf16* H = (bf16*)(ws + WS_H);
    bf16* ACT = (bf16*)(ws + WS_ACT);

    if (IN(0)) { p0_prologue(F); if (BOTH(0)) GRID_BAR(0); }
    if (IN(1)) { pg8::Gemm g{H, (const bf16*)(ws + WS_WGU), M, 2 * FF, D}; pg8::StaticOrder S; S.init(M, 2 * FF, F.G, (int)blockIdx.x);
        pg8::EpiSwiGLU E{ACT, FF};
        pg8::gemm_phase<pg8::EpiSwiGLU, pg8::StaticOrder, true, true>(F.lds + RING_OFF, g, S, E);
        if (BOTH(1)) GRID_BAR(1); }
    if (IN(2)) { pg8::Gemm g{ACT, (const bf16*)(ws + WS_WD), M, D, FF}; pg8::StaticOrder S; S.init(M, D, F.G, (int)blockIdx.x);
        pg8::EpiF32 E{F.out, D};
        pg8::gemm_phase<pg8::EpiF32, pg8::StaticOrder, true, true>(F.lds + RING_OFF, g, S, E);
        if (BOTH(2)) GRID_BAR(2); }
    if (IN(3)) { rows_phase(F, F.out, F.x, F.out, F.g_ffn1_post, 0.5f, F.g_mix_pre, H);
        convert_ffn_weights(F, F.w2g, F.w2u, F.w2d, (LAS float*)(F.lds + RING_OFF + F.wave * 16384));
        if (BOTH(3)) GRID_BAR(3); }
    if (IN(4)) { pg8::Gemm g{H, (const bf16*)(ws + WS_WIN), M, NPROJ, D}; pg8::StaticOrder S; S.init(M, NPROJ, F.G, (int)blockIdx.x);
        pg8::EpiProj E{(bf16*)(ws + WS_QKVS), (bf16*)(ws + WS_RET), (bf16*)(ws + WS_GATES), (const float*)(ws + WS_ROPE), (const float*)(ws + WS_ROPE) + 2048 * 64};
        pg8::gemm_phase<pg8::EpiProj, pg8::StaticOrder, true, true>(F.lds + RING_OFF, g, S, E);
        if (BOTH(4)) GRID_BAR(4); }
    if (IN(5)) { attn_naive(F); ret_naive(F); if (BOTH(5)) GRID_BAR(5); }
    if (IN(6)) { pg8::Gemm g{H, (const bf16*)(ws + WS_WP), M, 2 * D, D}; pg8::StaticOrder S; S.init(M, 2 * D, F.G, (int)blockIdx.x);
        pg8::EpiMerge E{(bf16*)(ws + WS_MERGED), (const bf16*)(ws + WS_GATES)};
        pg8::gemm_phase<pg8::EpiMerge, pg8::StaticOrder, true, true>(F.lds + RING_OFF, g, S, E);
        if (BOTH(6)) GRID_BAR(6); }
    if (IN(7)) { pg8::Gemm g{(const bf16*)(ws + WS_MERGED), (const bf16*)(ws + WS_WOUT), M, D, D}; pg8::StaticOrder S; S.init(M, D, F.G, (int)blockIdx.x);
        pg8::EpiF32 E{(float*)(ws + WS_Z), D};
        pg8::gemm_phase<pg8::EpiF32, pg8::StaticOrder, true, true>(F.lds + RING_OFF, g, S, E);
        if (BOTH(7)) GRID_BAR(7); }
    if (IN(8)) { rows_phase(F, (const float*)(ws + WS_Z), F.out, F.out, F.g_mix_post, 1.0f, F.g_ffn2_pre, H); if (BOTH(8)) GRID_BAR(8); }
    if (IN(9)) { pg8::Gemm g{H, (const bf16*)(ws + WS_WGU), M, 2 * FF, D}; pg8::StaticOrder S; S.init(M, 2 * FF, F.G, (int)blockIdx.x);
        pg8::EpiSwiGLU E{ACT, FF};
        pg8::gemm_phase<pg8::EpiSwiGLU, pg8::StaticOrder, true, true>(F.lds + RING_OFF, g, S, E);
        if (BOTH(9)) GRID_BAR(9); }
    if (IN(10)) { pg8::Gemm g{ACT, (const bf16*)(ws + WS_WD), M, D, FF}; pg8::StaticOrder S; S.init(M, D, F.G, (int)blockIdx.x);
        pg8::EpiF32 E{(float*)(ws + WS_Y2), D};
        pg8::gemm_phase<pg8::EpiF32, pg8::StaticOrder, true, true>(F.lds + RING_OFF, g, S, E);
        if (BOTH(10)) GRID_BAR(10); }
    if (IN(11)) { rows_phase(F, (const float*)(ws + WS_Y2), F.out, F.out, F.g_ffn2_post, 0.5f, nullptr, nullptr); }
#undef IN
#undef BOTH
}

extern "C" void kernel_launch(void* const* d_in, const int* in_sizes, int n_in, void* d_out, int out_size, void* d_ws, size_t ws_size, hipStream_t stream) {
    static int grid = 0;
    if (grid == 0) {
        if (n_in != 17 || in_sizes[0] != M * D || out_size != M * D || ws_size < WS_END) { fprintf(stderr, "kernel_launch: unexpected shapes: n_in %d in0 %d out %d ws %zu (need %zu)\n", n_in, n_in > 0 ? in_sizes[0] : -1, out_size, ws_size, (size_t)WS_END); grid = -1; return; }
        int dev = 0, cus = 0, per_cu = 0;
        if (hipGetDevice(&dev) != hipSuccess || hipDeviceGetAttribute(&cus, hipDeviceAttributeMultiprocessorCount, dev) != hipSuccess) { fprintf(stderr, "kernel_launch: device query failed\n"); grid = -1; return; }
        if (hipFuncSetAttribute((const void*)skel_fwd, hipFuncAttributeMaxDynamicSharedMemorySize, LDS_BYTES) != hipSuccess) { fprintf(stderr, "kernel_launch: hipFuncSetAttribute failed\n"); grid = -1; return; }
        if (hipOccupancyMaxActiveBlocksPerMultiprocessor(&per_cu, (const void*)skel_fwd, NWAVES * 64, LDS_BYTES) != hipSuccess || per_cu < 1)
            fprintf(stderr, "kernel_launch: note: occupancy query reports %d workgroups per CU\n", per_cu);
        (void)hipGetLastError();
        grid = cus;
        if (grid > 256) grid = 256;
    }
    if (grid < 0) return;
    if (hipMemsetAsync((char*)d_ws + WS_CTL, 0, CTL_ZERO_BYTES, stream) != hipSuccess) { fprintf(stderr, "kernel_launch: memset failed\n"); return; }
    Args a{};
    for (int i = 0; i < 17; ++i) a.in[i] = (const float*)d_in[i];
    a.out = (float*)d_out; a.ws = (unsigned char*)d_ws;
    for (int li = 0; li < N_LAUNCHES; ++li) {
        a.ph_lo = (N_LAUNCHES == NPHASE) ? li : 0; a.ph_hi = (N_LAUNCHES == NPHASE) ? li + 1 : NPHASE; a.li = li;
        hipLaunchKernelGGL(skel_fwd, dim3(grid), dim3(NWAVES * 64), LDS_BYTES, stream, a);
        const hipError_t le = hipPeekAtLastError();
        if (le != hipSuccess) { fprintf(stderr, "kernel_launch: launch %d failed: %s\n", li, hipGetErrorName(le)); break; }
    }
}
```

```cpp
#include <hip/hip_runtime.h>
#include <cstdio>
#include <cstdint>
#include <cmath>
namespace pg8 {
#define PG8_LAS __attribute__((address_space(3)))
typedef unsigned short bf16_t;
typedef short bf16x8 __attribute__((ext_vector_type(8)));
typedef float f32x4 __attribute__((ext_vector_type(4)));
typedef unsigned u32x4 __attribute__((ext_vector_type(4)));
constexpr int BM = 256, BK = 64, HALF = 128, HTB = HALF * BK * 2  , STAGE_BYTES = 8 * HTB, NXCD = 8, WGM = 8;

__host__ __device__ __forceinline__ int lds_byte(int r, int c) { const int st = (r >> 4) * 2 + (c >> 5), rr = r & 15, cc = c & 31, ob = rr * 64 + cc * 2; return st * 1024 + (ob ^ (((ob >> 9) & 1) << 5)); }
__host__ __device__ __forceinline__ void stage_rc(int b, int& R, int& C) { const int st = b / 1024, sb = b % 1024, swz = sb ^ (((sb >> 9) & 1) << 5); R = (st >> 1) * 16 + swz / 64; C = (st & 1) * 32 + (swz % 64) / 2; }
__host__ __device__ __forceinline__ int perm32(int rho) { const int n = rho >> 4, i = rho & 15; return 8 * (i >> 2) + 4 * n + (i & 3); }

struct Unit { int pm, pn; };
struct Gemm { const bf16_t* A; const bf16_t* Bt; int M, N, K; };

struct StaticOrder {
    int nM, nN, nwg, G, c;
    __host__ __device__ void init(int M, int N, int G_, int c_) { nM = M / BM; nN = N / BM; nwg = nM * nN; G = G_; c = c_; }
    __host__ __device__ bool next(int i, Unit& u) const {
        const long L = (long)i * G + c; if (L >= nwg) return false;
        int wgid = (int)L; { const int q = nwg / NXCD, r = nwg % NXCD, xcd = wgid % NXCD, off = wgid / NXCD; wgid = (xcd < r ? xcd * (q + 1) : r * (q + 1) + (xcd - r) * q) + off; }
        const int nig = WGM * nN, gid = wgid / nig, fm = gid * WGM, gsz = (nM - fm) < WGM ? (nM - fm) : WGM;
        u.pm = fm + ((wgid % nig) % gsz); u.pn = (wgid % nig) / gsz; return true;
    }
    __device__ __forceinline__ void a_ready(const Unit&) const {}
    __device__ __forceinline__ void done(const Unit&) const {}
};

__device__ __forceinline__ unsigned cvt_pk_bf16(float lo, float hi) { unsigned r; asm volatile("v_cvt_pk_bf16_f32 %0, %1, %2" : "=v"(r) : "v"(lo), "v"(hi)); return r; }
typedef float f32x2 __attribute__((ext_vector_type(2)));

__device__ __forceinline__ float fast_sigmoid(float x) { return __builtin_amdgcn_rcpf(1.0f + __expf(-x)); }
__device__ __forceinline__ float bf_lo(unsigned w) { return __uint_as_float(w << 16); }
__device__ __forceinline__ float bf_hi(unsigned w) { return __uint_as_float(w & 0xffff0000u); }

struct EpiSwiGLU {
    static constexpr bool PERM = true, AFTER_DRAIN = false;
    bf16_t* O; int ldc;
    __device__ __forceinline__ void operator()(const f32x4 (&acc)[2][2][4][2], const Unit& u, int wr, int wc, int fr, int fq) const {
        const int row0 = u.pm * BM + wr * 64 + fr, col0 = u.pn * HALF + wc * 32 + 8 * fq;
#pragma unroll
        for (int ai = 0; ai < 2; ++ai)
#pragma unroll
            for (int m = 0; m < 4; ++m) {
                bf16_t* rowp = O + (size_t)(row0 + ai * HALF + m * 16) * ldc + col0;
                float v[8];
#pragma unroll
                for (int n = 0; n < 2; ++n)
#pragma unroll
                    for (int e = 0; e < 4; ++e) { const float g = acc[ai][0][m][n][e], up = acc[ai][1][m][n][e]; v[4 * n + e] = g * fast_sigmoid(g) * up; }
                u32x4 w; w.x = cvt_pk_bf16(v[0], v[1]); w.y = cvt_pk_bf16(v[2], v[3]); w.z = cvt_pk_bf16(v[4], v[5]); w.w = cvt_pk_bf16(v[6], v[7]);
                *(u32x4*)rowp = w;
            }
    }
};

struct EpiF32 {
    static constexpr bool PERM = false, AFTER_DRAIN = false;
    float* O; int ldc;
    __device__ __forceinline__ void operator()(const f32x4 (&acc)[2][2][4][2], const Unit& u, int wr, int wc, int fr, int fq) const {
        const int row0 = u.pm * BM + wr * 64 + fr, col0 = u.pn * BM + wc * 32 + 4 * fq;
#pragma unroll
        for (int ai = 0; ai < 2; ++ai)
#pragma unroll
            for (int m = 0; m < 4; ++m) {
                float* rowp = O + (size_t)(row0 + ai * HALF + m * 16) * ldc + col0;
#pragma unroll
                for (int bj = 0; bj < 2; ++bj)
#pragma unroll
                    for (int n = 0; n < 2; ++n) *(f32x4*)(rowp + bj * HALF + n * 16) = acc[ai][bj][m][n];
            }
    }
};

struct EpiProj {
    static constexpr bool PERM = true, AFTER_DRAIN = false;
    bf16_t* QKVS; bf16_t* RET; bf16_t* GATES; const float* ropec; const float* ropes;
    __device__ __forceinline__ void operator()(const f32x4 (&acc)[2][2][4][2], const Unit& u, int wr, int wc, int fr, int fq) const {
        const int row0 = u.pm * BM + wr * 64 + fr; const int pn = u.pn;
        if (pn >= 6 && pn < 10) {
            const float sc = (pn >= 8) ? 0.08838834764831845f : 1.0f;
            const int hl = wc >> 1, i0 = 32 * (wc & 1) + 8 * fq;
            const int colb = (pn - 6) * BM + hl * 128 + i0;
#pragma unroll
            for (int ai = 0; ai < 2; ++ai)
#pragma unroll
                for (int m = 0; m < 4; ++m) {
                    const int row = row0 + ai * HALF + m * 16; const int pos = row & 2047;
                    const f32x4 c0 = *(const f32x4*)(ropec + pos * 64 + i0), c1 = *(const f32x4*)(ropec + pos * 64 + i0 + 4);
                    const f32x4 s0 = *(const f32x4*)(ropes + pos * 64 + i0), s1 = *(const f32x4*)(ropes + pos * 64 + i0 + 4);
                    float o1[8], o2[8];
#pragma unroll
                    for (int n = 0; n < 2; ++n)
#pragma unroll
                        for (int e = 0; e < 4; ++e) { const float x1 = acc[ai][0][m][n][e], x2 = acc[ai][1][m][n][e]; const float c = n ? c1[e] : c0[e], s = n ? s1[e] : s0[e];
                            o1[4 * n + e] = (x1 * c - x2 * s) * sc; o2[4 * n + e] = (x1 * s + x2 * c) * sc; }
                    bf16_t* rowp = RET + (size_t)row * 2048 + colb;
                    u32x4 w; w.x = cvt_pk_bf16(o1[0], o1[1]); w.y = cvt_pk_bf16(o1[2], o1[3]); w.z = cvt_pk_bf16(o1[4], o1[5]); w.w = cvt_pk_bf16(o1[6], o1[7]);
                    *(u32x4*)rowp = w;
                    w.x = cvt_pk_bf16(o2[0], o2[1]); w.y = cvt_pk_bf16(o2[2], o2[3]); w.z = cvt_pk_bf16(o2[4], o2[5]); w.w = cvt_pk_bf16(o2[6], o2[7]);
                    *(u32x4*)(rowp + 64) = w;
                }
            return;
        }
        bf16_t* base; int ldc, colt; float sc = 1.0f;
        if (pn < 6) { base = QKVS; ldc = 1536; colt = pn * BM; if (pn < 2) sc = 0.125f * 1.4426950408889634f; }
        else if (pn < 14) { base = RET; ldc = 2048; colt = (pn - 6) * BM; }
        else { base = GATES; ldc = 2048; colt = (pn - 14) * BM; }
        const int col0 = colt + wc * 32 + 8 * fq;
#pragma unroll
        for (int ai = 0; ai < 2; ++ai)
#pragma unroll
            for (int m = 0; m < 4; ++m) { bf16_t* rowp = base + (size_t)(row0 + ai * HALF + m * 16) * ldc + col0;
#pragma unroll
                for (int bj = 0; bj < 2; ++bj) { const f32x4 v0 = acc[ai][bj][m][0] * sc, v1 = acc[ai][bj][m][1] * sc;
                    u32x4 w; w.x = cvt_pk_bf16(v0[0], v0[1]); w.y = cvt_pk_bf16(v0[2], v0[3]); w.z = cvt_pk_bf16(v1[0], v1[1]); w.w = cvt_pk_bf16(v1[2], v1[3]);
                    *(u32x4*)(rowp + bj * HALF) = w; } }
    }
};

struct EpiMerge {
    static constexpr bool PERM = true, AFTER_DRAIN = false;
    bf16_t* O; const bf16_t* GATES;
    __device__ __forceinline__ void operator()(const f32x4 (&acc)[2][2][4][2], const Unit& u, int wr, int wc, int fr, int fq) const {
        const int row0 = u.pm * BM + wr * 64 + fr, col0 = u.pn * HALF + wc * 32 + 8 * fq;
#pragma unroll
        for (int ai = 0; ai < 2; ++ai)
#pragma unroll
            for (int m = 0; m < 4; ++m) {
                const size_t row = (size_t)(row0 + ai * HALF + m * 16);
                const u32x4 ga = *(const u32x4*)(GATES + row * 2048 + col0), gb = *(const u32x4*)(GATES + row * 2048 + 1024 + col0);
                float a[8], b[8];
                a[0] = bf_lo(ga.x); a[1] = bf_hi(ga.x); a[2] = bf_lo(ga.y); a[3] = bf_hi(ga.y); a[4] = bf_lo(ga.z); a[5] = bf_hi(ga.z); a[6] = bf_lo(ga.w); a[7] = bf_hi(ga.w);
                b[0] = bf_lo(gb.x); b[1] = bf_hi(gb.x); b[2] = bf_lo(gb.y); b[3] = bf_hi(gb.y); b[4] = bf_lo(gb.z); b[5] = bf_hi(gb.z); b[6] = bf_lo(gb.w); b[7] = bf_hi(gb.w);
                float v[8];
#pragma unroll
                for (int n = 0; n < 2; ++n)
#pragma unroll
                    for (int e = 0; e < 4; ++e) v[4 * n + e] = fast_sigmoid(a[4 * n + e]) * acc[ai][0][m][n][e] + fast_sigmoid(b[4 * n + e]) * acc[ai][1][m][n][e];
                u32x4 w; w.x = cvt_pk_bf16(v[0], v[1]); w.y = cvt_pk_bf16(v[2], v[3]); w.z = cvt_pk_bf16(v[4], v[5]); w.w = cvt_pk_bf16(v[6], v[7]);
                *(u32x4*)(O + row * 1024 + col0) = w;
            }
    }
};
template <class Epi, class Sched, bool ALIGN_EPI = false, bool SP2 = false>
__device__ __forceinline__ void gemm_phase(PG8_LAS unsigned char* lds, const Gemm g, const Sched& S, const Epi& E) {
    const int tid = threadIdx.x, wid = __builtin_amdgcn_readfirstlane(tid >> 6), lane = tid & 63, wr = wid >> 2, wc = wid & 3, fr = lane & 15, fq = lane >> 4;
    const int K = g.K, nt = K / BK;
    unsigned voffA[2], voffB[2];
#pragma unroll
    for (int i = 0; i < 2; ++i) { int R, C; stage_rc(tid * 16 + i * 8192, R, C); const int Rb = Epi::PERM ? ((R & ~31) + perm32(R & 31)) : R;
        voffA[i] = (unsigned)(R * K + C) * 2u; voffB[i] = (unsigned)(Rb * K + C) * 2u; }
    const size_t kstep = (size_t)(BK * 2);
    const size_t hstep = (size_t)HALF * K * 2;
    const size_t tstep = 2 * hstep;
    const unsigned ldsw = (unsigned)wid * 1024u;
    const int aoff = lds_byte(wr * 64 + fr, fq * 8), boff = lds_byte(wc * 32 + fr, fq * 8);
#define PG8_SA(b, h) (((b) * 2 + (h)) * HTB)
#define PG8_SB(b, h) ((4 + (b) * 2 + (h)) * HTB)
#define PG8_STAGE(bufoff, gbase, voff) do { _Pragma("unroll") for (int _i = 0; _i < 2; ++_i) \
        __builtin_amdgcn_global_load_lds((const unsigned*)((const char*)(gbase) + (voff)[_i]), (PG8_LAS unsigned*)(lds + (bufoff) + ldsw + _i * 8192), 16, 0, 0); } while (0)
#define PG8_LDA(dst, b, h) do { _Pragma("unroll") for (int m = 0; m < 4; ++m) _Pragma("unroll") for (int k = 0; k < 2; ++k) dst[m][k] = *(const PG8_LAS bf16x8*)(lds + PG8_SA(b, h) + aoff + m * 2048 + k * 1024); } while (0)
#define PG8_LDB(dst, b, h) do { _Pragma("unroll") for (int n = 0; n < 2; ++n) _Pragma("unroll") for (int k = 0; k < 2; ++k) dst[n][k] = *(const PG8_LAS bf16x8*)(lds + PG8_SB(b, h) + boff + n * 2048 + k * 1024); } while (0)
#define PG8_MMA(ai, bj, At, Bt) do { __builtin_amdgcn_s_setprio(1); _Pragma("unroll") for (int m = 0; m < 4; ++m) _Pragma("unroll") for (int n = 0; n < 2; ++n) _Pragma("unroll") for (int k = 0; k < 2; ++k) \
        acc[ai][bj][m][n] = __builtin_amdgcn_mfma_f32_16x16x32_bf16(Bt[n][k], At[m][k], acc[ai][bj][m][n], 0, 0, 0); __builtin_amdgcn_s_setprio(0); } while (0)
#define PG8_WAIT_V(n) asm volatile("s_waitcnt vmcnt(" #n ")" ::: "memory")
#define PG8_WAIT_L(n) asm volatile("s_waitcnt lgkmcnt(" #n ")" ::: "memory")
#define PG8_BAR __builtin_amdgcn_s_barrier()
#define PG8_SCHED __builtin_amdgcn_sched_barrier(0)
    Unit cur, nxt; int ui = 0;
    if (!S.next(0, cur)) return;
    f32x4 acc[2][2][4][2];
#pragma unroll
    for (int a = 0; a < 2; ++a)
#pragma unroll
        for (int b = 0; b < 2; ++b)
#pragma unroll
            for (int m = 0; m < 4; ++m)
#pragma unroll
                for (int n = 0; n < 2; ++n) acc[a][b][m][n] = (f32x4){0.f, 0.f, 0.f, 0.f};
    bf16x8 At[4][2], B0[2][2], B1[2][2];
    const char* cA = (const char*)g.A + (size_t)cur.pm * tstep; const char* cB = (const char*)g.Bt + (size_t)cur.pn * tstep;
    S.a_ready(cur);
    if constexpr (SP2) {
        PG8_STAGE(PG8_SB(0, 0), cB, voffB); PG8_STAGE(PG8_SB(0, 1), cB + hstep, voffB); PG8_STAGE(PG8_SA(0, 0), cA, voffA); PG8_STAGE(PG8_SA(0, 1), cA + hstep, voffA);
        if (wr == 1) PG8_BAR;
        PG8_WAIT_V(2); PG8_BAR;
        PG8_STAGE(PG8_SB(1, 0), cB + kstep, voffB); PG8_STAGE(PG8_SA(1, 0), cA + kstep, voffA); PG8_STAGE(PG8_SB(1, 1), cB + hstep + kstep, voffB);
        PG8_WAIT_V(6); PG8_BAR;
    } else {
        PG8_STAGE(PG8_SB(0, 0), cB, voffB); PG8_STAGE(PG8_SA(0, 0), cA, voffA); PG8_STAGE(PG8_SB(0, 1), cB + hstep, voffB); PG8_STAGE(PG8_SA(0, 1), cA + hstep, voffA);
        if (wr == 1) PG8_BAR;
        PG8_WAIT_V(4); PG8_BAR;
        PG8_STAGE(PG8_SB(1, 0), cB + kstep, voffB); PG8_STAGE(PG8_SA(1, 0), cA + kstep, voffA); PG8_STAGE(PG8_SB(1, 1), cB + hstep + kstep, voffB);
        PG8_WAIT_V(6); PG8_BAR;
    }
    for (;;) {
        const bool has_next = S.next(ui + 1, nxt);
        const char* nA = has_next ? (const char*)g.A + (size_t)nxt.pm * tstep : cA; const char* nB = has_next ? (const char*)g.Bt + (size_t)nxt.pn * tstep : cB;
        for (int t = 0; t < nt; t += 2) {
            const bool last = (t == nt - 2);
            const char* a1 = cA + (size_t)(t + 1) * kstep;
            const char* a2 = last ? nA : cA + (size_t)(t + 2) * kstep; const char* b2 = last ? nB : cB + (size_t)(t + 2) * kstep;
            const char* a3 = a2 + kstep; const char* b3 = b2 + kstep;
            if (last && has_next) S.a_ready(nxt);
            if constexpr (SP2) {
            PG8_LDB(B0, 0, 0); PG8_LDB(B1, 0, 1); PG8_SCHED; PG8_LDA(At, 0, 0); PG8_STAGE(PG8_SA(1, 1), a1 + hstep, voffA);
            PG8_WAIT_V(8); PG8_WAIT_L(0); PG8_BAR; PG8_MMA(0, 0, At, B0); PG8_MMA(0, 1, At, B1); PG8_BAR; PG8_SCHED;
            PG8_LDA(At, 0, 1); PG8_STAGE(PG8_SB(0, 0), b2, voffB); PG8_STAGE(PG8_SB(0, 1), b2 + hstep, voffB); PG8_STAGE(PG8_SA(0, 0), a2, voffA);
            PG8_WAIT_V(8); PG8_WAIT_L(0); PG8_BAR; PG8_MMA(1, 0, At, B0); PG8_MMA(1, 1, At, B1); PG8_BAR; PG8_SCHED;
            PG8_LDB(B0, 1, 0); PG8_LDB(B1, 1, 1); PG8_SCHED; PG8_LDA(At, 1, 0); PG8_STAGE(PG8_SA(0, 1), a2 + hstep, voffA);
            PG8_WAIT_V(8); PG8_WAIT_L(0); PG8_BAR; PG8_MMA(0, 0, At, B0); PG8_MMA(0, 1, At, B1); PG8_BAR; PG8_SCHED;
            PG8_LDA(At, 1, 1); PG8_STAGE(PG8_SB(1, 0), b3, voffB); PG8_STAGE(PG8_SB(1, 1), b3 + hstep, voffB); PG8_STAGE(PG8_SA(1, 0), a3, voffA);
            PG8_WAIT_V(8); PG8_WAIT_L(0); PG8_BAR; PG8_MMA(1, 0, At, B0); PG8_MMA(1, 1, At, B1); PG8_BAR; PG8_SCHED;
            } else {
            PG8_LDB(B0, 0, 0); PG8_SCHED; PG8_LDA(At, 0, 0); PG8_STAGE(PG8_SA(1, 1), a1 + hstep, voffA);
            PG8_WAIT_L(8); PG8_BAR; PG8_WAIT_L(0); PG8_MMA(0, 0, At, B0); PG8_BAR; PG8_SCHED;
            PG8_LDB(B1, 0, 1); PG8_STAGE(PG8_SB(0, 0), b2, voffB);
            PG8_BAR; PG8_WAIT_L(0); PG8_MMA(0, 1, At, B1); PG8_BAR;
            PG8_LDA(At, 0, 1); PG8_STAGE(PG8_SA(0, 0), a2, voffA);
            PG8_BAR; PG8_WAIT_L(0); PG8_MMA(1, 0, At, B0); PG8_BAR; PG8_SCHED;
            PG8_STAGE(PG8_SB(0, 1), b2 + hstep, voffB);
            PG8_WAIT_V(6); PG8_BAR; PG8_MMA(1, 1, At, B1); PG8_BAR;
            PG8_LDB(B0, 1, 0); PG8_SCHED; PG8_LDA(At, 1, 0); PG8_STAGE(PG8_SA(0, 1), a2 + hstep, voffA);
            PG8_WAIT_L(8); PG8_BAR; PG8_WAIT_L(0); PG8_MMA(0, 0, At, B0); PG8_BAR; PG8_SCHED;
            PG8_LDB(B1, 1, 1); PG8_STAGE(PG8_SB(1, 0), b3, voffB);
            PG8_BAR; PG8_WAIT_L(0); PG8_MMA(0, 1, At, B1); PG8_BAR;
            PG8_LDA(At, 1, 1); PG8_STAGE(PG8_SA(1, 0), a3, voffA);
            PG8_BAR; PG8_WAIT_L(0); PG8_MMA(1, 0, At, B0); PG8_BAR; PG8_SCHED;
            PG8_STAGE(PG8_SB(1, 1), b3 + hstep, voffB);
            PG8_WAIT_V(6); PG8_BAR; PG8_MMA(1, 1, At, B1); PG8_BAR;
            }
        }
        if constexpr (ALIGN_EPI) { if (wr == 0) PG8_BAR; }
        if constexpr (!Epi::AFTER_DRAIN) { E(acc, cur, wr, wc, fr, fq); S.done(cur); }
        if (!has_next) break;
#pragma unroll
        for (int a = 0; a < 2; ++a)
#pragma unroll
            for (int b = 0; b < 2; ++b)
#pragma unroll
                for (int m = 0; m < 4; ++m)
#pragma unroll
                    for (int n = 0; n < 2; ++n) acc[a][b][m][n] = (f32x4){0.f, 0.f, 0.f, 0.f};
        cur = nxt; cA = nA; cB = nB; ++ui;
        if constexpr (ALIGN_EPI) { if (wr == 1) PG8_BAR; }
    }
    PG8_WAIT_V(0);
    if constexpr (!ALIGN_EPI) { if (wr == 0) PG8_BAR; }
    PG8_BAR;
    if constexpr (Epi::AFTER_DRAIN) { E.fused(acc, cur, wr, wc, fr, fq, lds, wid, lane); S.done(cur); }
#undef PG8_SA
#undef PG8_SB
#undef PG8_STAGE
#undef PG8_LDA
#undef PG8_LDB
#undef PG8_MMA
#undef PG8_WAIT_V
#undef PG8_WAIT_L
#undef PG8_BAR
#undef PG8_SCHED
}
}
#define GAS __attribute__((address_space(1)))
#define LAS __attribute__((address_space(3)))
typedef unsigned short bf16;
typedef unsigned v4u __attribute__((ext_vector_type(4)));
typedef float f32x4 __attribute__((ext_vector_type(4)));
typedef short bf16x8 __attribute__((ext_vector_type(8)));
typedef GAS unsigned gu32;
typedef GAS unsigned long long gu64;
#define RLX_AGENT __ATOMIC_RELAXED, __HIP_MEMORY_SCOPE_AGENT
#define LDS_WAIT() asm volatile("s_waitcnt lgkmcnt(0)" ::: "memory")
#define VM_WAIT() asm volatile("s_waitcnt vmcnt(0)" ::: "memory")
__device__ __forceinline__ unsigned long long rt() { return __builtin_amdgcn_s_memrealtime(); }
__device__ __forceinline__ unsigned f2bf(float f) { unsigned u = __builtin_bit_cast(unsigned, f); return (u + 0x7fffu + ((u >> 16) & 1u)) >> 16; }
__device__ __forceinline__ unsigned pk2(float lo, float hi) { return f2bf(lo) | (f2bf(hi) << 16); }

#define XB_TMO      128
#define XB_XCNT(j)  (256  + 64 * (j))
#define XB_XSUB(j)  (1280 + 64 * (j))
#define XB_XGEN(j)  (2304 + 64 * (j))
#define XB_TOP      3328
#define XB_TOPGEN   3392
#define XCD_BAR_WORDS 3456
#define XB_SPIN_CAP (1u << 18)

__device__ __forceinline__ unsigned xb_ld(unsigned* p)              { return __hip_atomic_load(p, __ATOMIC_RELAXED, __HIP_MEMORY_SCOPE_AGENT); }
__device__ __forceinline__ unsigned xb_add(unsigned* p, unsigned v) { return __hip_atomic_fetch_add(p, v, __ATOMIC_RELAXED, __HIP_MEMORY_SCOPE_AGENT); }
__device__ __forceinline__ unsigned xb_xcc_id() { return (unsigned)__builtin_amdgcn_s_getreg((3 << 11) | 20) & 0xFu; }
#define XB_SPIN(cond, bar) do { unsigned _sp = 0; while (cond) { __builtin_amdgcn_s_sleep(1); \
    if ((++_sp & 255u) == 0u) { if (xb_ld(&(bar)[XB_TMO])) break; if (_sp > XB_SPIN_CAP) { atomicAdd(&(bar)[XB_TMO], 1u); break; } } } } while (0)

struct XcdBarrier {
    unsigned* bar; unsigned x;
    volatile LAS unsigned* st;
};

__device__ __forceinline__ XcdBarrier xcd_barrier_post(unsigned* bar, volatile LAS unsigned* st) {
    XcdBarrier b; b.bar = bar; b.x = xb_xcc_id(); b.st = st;
    if (threadIdx.x == 0) (void)xb_add(&bar[XB_XCNT(b.x)], 1u);
    return b;
}
__device__ __forceinline__ void xcd_barrier_complete(unsigned* bar, unsigned x, unsigned& nloc, unsigned& nx) {
    const unsigned G = gridDim.x * gridDim.y * gridDim.z;
    unsigned sum, cnt, mine, sp = 0u;
    for (;;) {
        sum = 0u; cnt = 0u; mine = 0u;
#pragma unroll
        for (unsigned j = 0; j < 16; ++j) { const unsigned c = xb_ld(&bar[XB_XCNT(j)]); sum += c; cnt += (c > 0u) ? 1u : 0u; mine = (j == x) ? c : mine; }
        if (sum == G) break;
        __builtin_amdgcn_s_sleep(1);
        if ((++sp & 255u) == 0u) { if (xb_ld(&bar[XB_TMO])) break; if (sp > XB_SPIN_CAP) { atomicAdd(&bar[XB_TMO], 1u); break; } }
    }
    nloc = mine > 0u ? mine : 1u; nx = cnt > 0u ? cnt : 1u;
}

__device__ __forceinline__ void xcd_barrier(const XcdBarrier& b) {
    asm volatile("s_waitcnt vmcnt(0)" ::: "memory");
    __syncthreads();
    if (threadIdx.x == 0) {
        unsigned* bar = b.bar;
        __builtin_amdgcn_s_waitcnt(0);
        unsigned nloc = b.st[0], nx = b.st[1];
        if (nloc == 0u) { xcd_barrier_complete(bar, b.x, nloc, nx); b.st[0] = nloc; b.st[1] = nx; }
        const unsigned old = xb_add(&bar[XB_XSUB(b.x)], 1u);
        const unsigned gen = old / nloc;
        if (old + 1u == (gen + 1u) * nloc) {
            __builtin_amdgcn_fence(__ATOMIC_RELEASE, "agent");
            asm volatile("s_waitcnt vmcnt(0)" ::: "memory");
            const unsigned og = xb_add(&bar[XB_TOP], 1u);
            const unsigned tg = og / nx;
            if (og + 1u == (tg + 1u) * nx) xb_add(&bar[XB_TOPGEN], 1u);
            else XB_SPIN(xb_ld(&bar[XB_TOPGEN]) == tg, bar);
            __builtin_amdgcn_fence(__ATOMIC_ACQUIRE, "agent");
            xb_add(&bar[XB_XGEN(b.x)], 1u);
            asm volatile("s_waitcnt vmcnt(0)" ::: "memory");
        } else {
            XB_SPIN(xb_ld(&bar[XB_XGEN(b.x)]) == gen, bar);
            __builtin_amdgcn_fence(__ATOMIC_ACQUIRE, "agent");
            asm volatile("s_waitcnt vmcnt(0)" ::: "memory");
        }
    }
    __syncthreads();
}

constexpr int NWAVES = 8;
#ifndef MK_N_LAUNCHES
#define MK_N_LAUNCHES 1
#endif
constexpr int N_LAUNCHES = MK_N_LAUNCHES;
constexpr int NPHASE = 12;
constexpr int BATCH = 8, SEQ = 2048, D = 1024, FF = 4096, M = BATCH * SEQ;
constexpr int NPROJ = 5632;
constexpr float RMS_EPS = 1e-6f, GN_EPS = 1e-5f;

constexpr size_t MiB = 1u << 20;
constexpr size_t WS_CTL = 0, CTL_ZERO_BYTES = 1 * MiB;
constexpr size_t WS_ROPE = 1 * MiB;
constexpr size_t WS_WD = 2 * MiB;
constexpr size_t WS_H = 10 * MiB;
constexpr size_t WS_WIN = 42 * MiB;
constexpr size_t WS_WP = 53 * MiB;
constexpr size_t WS_WOUT = 57 * MiB;
constexpr size_t WS_WGU = 59 * MiB;
constexpr size_t WS_Y2 = 10 * MiB;
constexpr size_t WS_BIG = 75 * MiB;
constexpr size_t WS_ACT = WS_BIG;
constexpr size_t WS_QKVS = WS_BIG;
constexpr size_t WS_RET = WS_BIG + 48 * MiB;
constexpr size_t WS_GATES = WS_BIG + 112 * MiB;
constexpr size_t WS_MERGED = WS_BIG;
constexpr size_t WS_Z = WS_BIG + 48 * MiB;
constexpr size_t WS_END = 251 * MiB;
static_assert(WS_Y2 + (size_t)M * D * 4 <= WS_BIG && WS_GATES + (size_t)M * 2048 * 2 <= WS_END && WS_WGU + (size_t)8192 * 1024 * 2 <= WS_BIG, "ws map");
constexpr int CW_TMO = 0, CW_CODE = 1;
constexpr int CW_BAR = 4096;

constexpr int RING_OFF = 0, RING_BYTES = 131072;
constexpr int LDSCTL_OFF = RING_BYTES, MISC_OFF = LDSCTL_OFF + 320;
constexpr int LDS_BYTES = 147456;

namespace sba {
typedef float f32x16 __attribute__((ext_vector_type(16)));
typedef short s16x4 __attribute__((ext_vector_type(4)));
typedef short v4i16_t __attribute__((ext_vector_type(4)));
constexpr int KPITCH = 144, KBUF = 64 * KPITCH, VBUF = 8192, BUFSZ = KBUF + VBUF, FLAG_OFF = 2 * BUFSZ, OST_OFF = FLAG_OFF + 64;
constexpr float A_DONE = 150.0f;
__device__ __forceinline__ int crow(int r, int hi) { return (r & 3) + 8 * (r >> 2) + 4 * hi; }
__device__ __forceinline__ s16x4 vtr(const LAS unsigned char* p) { return __builtin_bit_cast(s16x4, __builtin_amdgcn_ds_read_tr16_b64_v4i16((LAS v4i16_t*)p)); }
__device__ __forceinline__ unsigned cvtpk(float lo, float hi) { unsigned r; asm volatile("v_cvt_pk_bf16_f32 %0, %1, %2" : "=v"(r) : "v"(lo), "v"(hi)); return r; }

__device__ __forceinline__ void attn_unit(LAS unsigned char* lds, const bf16* QKVS, bf16* O2, int b, int h, int qb, int tid, int lane, int wave) {
    const int r32 = lane & 31, hi = lane >> 5;
    const int q0w = 256 * qb + 32 * wave;
    const size_t rowbase = (size_t)b * SEQ;
    bf16x8 qf[4];
#pragma unroll
    for (int ks = 0; ks < 4; ++ks) qf[ks] = *(const GAS bf16x8*)(QKVS + (rowbase + q0w + r32) * 1536 + h * 64 + 16 * ks + 8 * hi);
    f32x16 o0, o1;
#pragma unroll
    for (int i = 0; i < 16; ++i) { o0[i] = 0.f; o1[i] = 0.f; }
    float carry = 0.f;
    const int Ttop = 4 * qb + 3, wstart = 4 * qb + (wave >> 1);
    const int skey = tid >> 3, schunk = tid & 7;
    const bf16* gK = QKVS + (rowbase + skey) * 1536 + 512 + h * 64 + schunk * 8;
    const bf16* gV = gK + 512;
    const int kst = skey * KPITCH + schunk * 16, vst = KBUF + (schunk >> 2) * 4096 + skey * 64 + (schunk & 3) * 16;
    volatile LAS unsigned* flags = (volatile LAS unsigned*)(lds + FLAG_OFF);
    __syncthreads();
    v4u kreg = *(const GAS v4u*)(gK + (size_t)Ttop * 64 * 1536), vreg = *(const GAS v4u*)(gV + (size_t)Ttop * 64 * 1536);
    *(LAS v4u*)(lds + kst) = kreg; *(LAS v4u*)(lds + vst) = vreg;
    __syncthreads();
    int cur = 0;
    const int vlane = (4 * hi + ((lane & 15) >> 2)) * 64 + (((lane >> 4) & 1) * 16 + (lane & 3) * 4) * 2;
    for (int T = Ttop; T >= 0; --T) {
        if (T > 0) { kreg = *(const GAS v4u*)(gK + (size_t)(T - 1) * 64 * 1536); vreg = *(const GAS v4u*)(gV + (size_t)(T - 1) * 64 * 1536); }
        if (T <= wstart) {
            const LAS unsigned char* kb = lds + cur * BUFSZ; const LAS unsigned char* vb = kb + KBUF;
            f32x16 p0, p1;
#pragma unroll
            for (int i = 0; i < 16; ++i) { p0[i] = 0.f; p1[i] = 0.f; }
#pragma unroll
            for (int ks = 0; ks < 4; ++ks) {
                const bf16x8 a0 = *(const LAS bf16x8*)(kb + r32 * KPITCH + (2 * ks + hi) * 16);
                const bf16x8 a1 = *(const LAS bf16x8*)(kb + (32 + r32) * KPITCH + (2 * ks + hi) * 16);
                p0 = __builtin_amdgcn_mfma_f32_32x32x16_bf16(a0, qf[ks], p0, 0, 0, 0);
                p1 = __builtin_amdgcn_mfma_f32_32x32x16_bf16(a1, qf[ks], p1, 0, 0, 0);
            }
            const bool diag = (T == wstart);
            const int qrel = 32 * (wave & 1) + r32;
            float sp[2][16], xx[2][16];
#pragma unroll
            for (int blk = 0; blk < 2; ++blk)
#pragma unroll
                for (int r = 0; r < 16; ++r) {
                    const float z = blk ? p1[r] : p0[r];
                    const float e1 = __builtin_amdgcn_exp2f(-fabsf(z));
                    float s = fmaxf(z, 0.f) + __builtin_amdgcn_logf(1.0f + e1);
                    if (diag && (32 * blk + crow(r, hi) >= qrel)) s = 0.f;
                    sp[blk][r] = s; xx[blk][r] = z - s;
                }
            float Tq[2][4], lo[2][4];
#pragma unroll
            for (int blk = 0; blk < 2; ++blk)
#pragma unroll
                for (int g = 0; g < 4; ++g) {
                    const float qs = (sp[blk][4 * g] + sp[blk][4 * g + 1]) + (sp[blk][4 * g + 2] + sp[blk][4 * g + 3]);
                    auto rr = __builtin_amdgcn_permlane32_swap(__float_as_uint(qs), __float_as_uint(qs), false, false);
                    const float f0 = __uint_as_float(rr[0]), f1 = __uint_as_float(rr[1]);
                    Tq[blk][g] = f0 + f1; lo[blk][g] = hi ? 0.f : f1;
                }
            float run = carry; float w[2][16];
#pragma unroll
            for (int blk = 1; blk >= 0; --blk)
#pragma unroll
                for (int g = 3; g >= 0; --g) {
                    const float a3 = run + lo[blk][g]; const float a2 = a3 + sp[blk][4 * g + 3]; const float a1 = a2 + sp[blk][4 * g + 2]; const float a0 = a1 + sp[blk][4 * g + 1];
                    w[blk][4 * g + 3] = __builtin_amdgcn_exp2f(xx[blk][4 * g + 3] - a3); w[blk][4 * g + 2] = __builtin_amdgcn_exp2f(xx[blk][4 * g + 2] - a2);
                    w[blk][4 * g + 1] = __builtin_amdgcn_exp2f(xx[blk][4 * g + 1] - a1); w[blk][4 * g + 0] = __builtin_amdgcn_exp2f(xx[blk][4 * g + 0] - a0);
                    run += Tq[blk][g];
                }
            carry = run;
            if (diag) {
#pragma unroll
                for (int blk = 0; blk < 2; ++blk)
#pragma unroll
                    for (int r = 0; r < 16; ++r) if (32 * blk + crow(r, hi) >= qrel) w[blk][r] = 0.f;
            }
            bf16x8 pf[4];
#pragma unroll
            for (int s4 = 0; s4 < 4; ++s4) { const int blk = s4 >> 1, s = s4 & 1; v4u t;
                t.x = cvtpk(w[blk][8 * s + 0], w[blk][8 * s + 1]); t.y = cvtpk(w[blk][8 * s + 2], w[blk][8 * s + 3]); t.z = cvtpk(w[blk][8 * s + 4], w[blk][8 * s + 5]); t.w = cvtpk(w[blk][8 * s + 6], w[blk][8 * s + 7]);
                pf[s4] = __builtin_bit_cast(bf16x8, t); }
#pragma unroll
            for (int s4 = 0; s4 < 4; ++s4) {
#pragma unroll
                for (int d0 = 0; d0 < 2; ++d0) {
                    const LAS unsigned char* vp = vb + d0 * 4096 + s4 * 16 * 64 + vlane;
                    const s16x4 l4 = vtr(vp), h4 = vtr(vp + 8 * 64);
                    const bf16x8 bv = (bf16x8){l4[0], l4[1], l4[2], l4[3], h4[0], h4[1], h4[2], h4[3]};
                    if (d0 == 0) o0 = __builtin_amdgcn_mfma_f32_32x32x16_bf16(pf[s4], bv, o0, 0, 0, 0);
                    else o1 = __builtin_amdgcn_mfma_f32_32x32x16_bf16(pf[s4], bv, o1, 0, 0, 0);
                }
            }
        }
        const int wdone = __all(carry >= A_DONE) ? 1 : 0;
        if (lane == 0) flags[(T & 1) * 8 + wave] = (unsigned)wdone;
        if (T > 0) { *(LAS v4u*)(lds + (cur ^ 1) * BUFSZ + kst) = kreg; *(LAS v4u*)(lds + (cur ^ 1) * BUFSZ + vst) = vreg; }
        __syncthreads();
        unsigned alld = 1u;
#pragma unroll
        for (int i = 0; i < 8; ++i) alld &= flags[(T & 1) * 8 + i];
        if (alld) break;
        cur ^= 1;
    }
#pragma unroll
    for (int r = 0; r < 16; ++r) {
        bf16* op = O2 + (rowbase + q0w + crow(r, hi)) * 1024 + h * 64 + r32;
        op[0] = (bf16)f2bf(o0[r]); op[32] = (bf16)f2bf(o1[r]);
    }
}
}

struct Frame {
    LAS unsigned char* lds;
    volatile LAS unsigned* MISC;
    gu32* ctl;
    int tid, lane, wave;
    int vcu, G;
    const float* x; float* out;
    const float *g_ffn1_pre, *g_ffn1_post, *w1g, *w1u, *w1d, *g_mix_pre, *w_in, *w_psb, *w_pret, *w_out, *g_mix_post, *g_ffn2_pre, *g_ffn2_post, *w2g, *w2u, *w2d;
    unsigned char* ws;
};

__device__ __forceinline__ float wave_sum(float v) {
#pragma unroll
    for (int o = 1; o < 64; o <<= 1) v += __shfl_xor(v, o);
    return v;
}

__device__ __forceinline__ void tr_block(const float* W, int ldw, int k0, int n0, bf16* WT, int ldt, int drow0, int dk0, LAS float* scr, int lane) {
#pragma unroll 8
    for (int i = 0; i < 32; ++i) { const int kk = 2 * i + (lane >> 5); scr[kk * 33 + (lane & 31)] = W[(size_t)(k0 + kk) * ldw + n0 + (lane & 31)]; }
    LDS_WAIT(); asm volatile("" ::: "memory");
    const int c = lane & 7;
#pragma unroll
    for (int j = 0; j < 4; ++j) { const int n = (lane >> 3) + 8 * j; const LAS float* s = scr + (8 * c) * 33 + n;
        v4u o; o.x = pk2(s[0 * 33], s[1 * 33]); o.y = pk2(s[2 * 33], s[3 * 33]); o.z = pk2(s[4 * 33], s[5 * 33]); o.w = pk2(s[6 * 33], s[7 * 33]);
        *(GAS v4u*)(WT + (size_t)(drow0 + n) * ldt + dk0 + 8 * c) = o; }
    LDS_WAIT(); asm volatile("" ::: "memory");
}
__device__ __forceinline__ void tr_job(int kind, const float* W, int K, int N, bf16* WT, int ldt, int item, LAS float* scr, int lane) {
    const int nblk = N / 32, kb = item / nblk, nb = item % nblk, k0 = 64 * kb, n0 = 32 * nb;
    int drow0 = n0, dk0 = k0;
    if (kind == 1) drow0 = 256 * (n0 >> 7) + (n0 & 127);
    else if (kind == 2) drow0 = 256 * (n0 >> 7) + 128 + (n0 & 127);
    else if (kind == 3) { const int tile = n0 >> 8; if (tile >= 6 && tile < 10) { const int local = n0 & 255, hl = local >> 7, within = local & 127, half = within >> 6, i0 = within & 63; drow0 = 256 * tile + 128 * half + 64 * hl + i0; } }
    else if (kind == 4) drow0 = 256 * (n0 >> 7) + (n0 & 127);
    else if (kind == 5) { drow0 = 256 * (n0 >> 7) + 128 + (n0 & 127); dk0 = 512 + k0; }
    tr_block(W, N, k0, n0, WT, ldt, drow0, dk0, scr, lane);
}

__device__ __forceinline__ void rms_to_bf16(const f32x4 (&v)[4], const float* g, bf16* orow, int lane) {
    float s = 0.f;
#pragma unroll
    for (int j = 0; j < 4; ++j) s += (v[j].x * v[j].x + v[j].y * v[j].y) + (v[j].z * v[j].z + v[j].w * v[j].w);
    const float rs = 1.0f / sqrtf(wave_sum(s) * (1.f / D) + RMS_EPS);
    GAS unsigned long long* o8 = (GAS unsigned long long*)orow + lane;
#pragma unroll
    for (int j = 0; j < 4; ++j) { const f32x4 gg = ((const GAS f32x4*)g)[lane + 64 * j];
        o8[64 * j] = (unsigned long long)pk2(v[j].x * rs * gg.x, v[j].y * rs * gg.y) | ((unsigned long long)pk2(v[j].z * rs * gg.z, v[j].w * rs * gg.w) << 32); }
}
__device__ __forceinline__ void rows_phase(Frame& F, const float* Y, const float* xres, float* xo, const float* g_post, float coef, const float* g_pre, bf16* hn) {
    const int gw = F.vcu * NWAVES + F.wave, NGW = F.G * NWAVES;
    for (int m = gw; m < M; m += NGW) {
        const GAS f32x4* yr = (const GAS f32x4*)(Y + (size_t)m * D) + F.lane;
        const GAS f32x4* xr = (const GAS f32x4*)(xres + (size_t)m * D) + F.lane;
        f32x4 y[4], xv[4]; float s = 0.f;
#pragma unroll
        for (int j = 0; j < 4; ++j) { y[j] = yr[64 * j]; xv[j] = xr[64 * j]; s += (y[j].x * y[j].x + y[j].y * y[j].y) + (y[j].z * y[j].z + y[j].w * y[j].w); }
        const float rs = coef / sqrtf(wave_sum(s) * (1.f / D) + RMS_EPS);
        GAS f32x4* orow = (GAS f32x4*)(xo + (size_t)m * D) + F.lane;
#pragma unroll
        for (int j = 0; j < 4; ++j) { const f32x4 gg = ((const GAS f32x4*)g_post)[F.lane + 64 * j]; xv[j] = xv[j] + y[j] * gg * rs; orow[64 * j] = xv[j]; }
        if (hn) rms_to_bf16(xv, g_pre, hn + (size_t)m * D, F.lane);
    }
}

__device__ __forceinline__ void convert_ffn_weights(Frame& F, const float* wg, const float* wu, const float* wd, LAS float* scr) {
    const int gw = F.vcu * NWAVES + F.wave, NGW = F.G * NWAVES;
    bf16* WGU = (bf16*)(F.ws + WS_WGU); bf16* WD = (bf16*)(F.ws + WS_WD);
    constexpr int I_G = (D / 64) * (FF / 32), I_D = (FF / 64) * (D / 32);
    for (int it = gw; it < 2 * I_G + I_D; it += NGW) {
        int r = it;
        if (r < I_G) { tr_job(1, wg, D, FF, WGU, D, r, scr, F.lane); continue; } r -= I_G;
        if (r < I_G) { tr_job(2, wu, D, FF, WGU, D, r, scr, F.lane); continue; } r -= I_G;
        tr_job(0, wd, FF, D, WD, FF, r, scr, F.lane);
    }
}

__device__ __forceinline__ void p0_prologue(Frame& F) {
    LAS float* scr = (LAS float*)(F.lds + RING_OFF + F.wave * 16384);
    const int gw = F.vcu * NWAVES + F.wave, NGW = F.G * NWAVES;
    convert_ffn_weights(F, F.w1g, F.w1u, F.w1d, scr);
    bf16* WIN = (bf16*)(F.ws + WS_WIN); bf16* WP = (bf16*)(F.ws + WS_WP); bf16* WOUT = (bf16*)(F.ws + WS_WOUT);
    constexpr int I_IN = (D / 64) * (NPROJ / 32), I_P = (512 / 64) * (D / 32), I_O = (D / 64) * (D / 32);
    for (int it = gw; it < I_IN + 2 * I_P + I_O; it += NGW) {
        int r = it;
        if (r < I_IN) { tr_job(3, F.w_in, D, NPROJ, WIN, D, r, scr, F.lane); continue; } r -= I_IN;
        if (r < I_P) { tr_job(4, F.w_psb, 512, D, WP, D, r, scr, F.lane); continue; } r -= I_P;
        if (r < I_P) { tr_job(5, F.w_pret, 512, D, WP, D, r, scr, F.lane); continue; } r -= I_P;
        tr_job(0, F.w_out, D, D, WOUT, D, r, scr, F.lane);
    }
    for (int r = gw; r < 2048; r += NGW) { const int kz = ((r & 255) < 128) ? 512 : 0; *(GAS v4u*)(WP + (size_t)r * 1024 + kz + 8 * F.lane) = (v4u){0u, 0u, 0u, 0u}; }
    { float* ct = (float*)(F.ws + WS_ROPE); float* st = ct + 2048 * 64;
      for (int idx = (F.vcu * NWAVES + F.wave) * 64 + F.lane; idx < 2048 * 64; idx += F.G * NWAVES * 64) {
          const int pos = idx >> 6, i = idx & 63;
          const float inv_freq = exp2f(-(float)i * (13.287712379549449f / 64.0f));
          const float ang = (float)pos * inv_freq;
          const double a = (double)ang; const double k = __builtin_rint(a * 0.15915494309189535);
          const double r = __builtin_fma(-k, 6.283185307179586, a) - k * 2.4492935982947064e-16;
          const float rf = (float)r; ct[idx] = cosf(rf); st[idx] = sinf(rf); } }
    bf16* H = (bf16*)(F.ws + WS_H);
    for (int m = gw; m < M; m += NGW) { const GAS f32x4* xr = (const GAS f32x4*)(F.x + (size_t)m * D) + F.lane; f32x4 v[4];
#pragma unroll
        for (int j = 0; j < 4; ++j) v[j] = xr[64 * j];
        rms_to_bf16(v, F.g_ffn1_pre, H + (size_t)m * D, F.lane); }
}

__device__ __forceinline__ void unpack8(const v4u w, float* f) {
    f[0] = __uint_as_float(w.x << 16); f[1] = __uint_as_float(w.x & 0xffff0000u); f[2] = __uint_as_float(w.y << 16); f[3] = __uint_as_float(w.y & 0xffff0000u);
    f[4] = __uint_as_float(w.z << 16); f[5] = __uint_as_float(w.z & 0xffff0000u); f[6] = __uint_as_float(w.w << 16); f[7] = __uint_as_float(w.w & 0xffff0000u);
}
__device__ __forceinline__ float bf2f(bf16 v) { return __uint_as_float((unsigned)v << 16); }

__device__ __forceinline__ void attn_naive(Frame& F) {
    const bf16* QKVS = (const bf16*)(F.ws + WS_QKVS); bf16* O2 = (bf16*)(F.ws + WS_H);
    const int bx = blockIdx.x;
    for (int bh = bx >> 2; bh < 64; bh += (F.G >> 2)) {
        const int q4 = bx & 3, wv = F.wave;
        const int tb = wv < 4 ? q4 * 4 + wv : 31 - (q4 * 4 + (wv - 4));
        const int t = tb * 64 + F.lane, b = bh >> 3, h = bh & 7;
        const bf16* base = QKVS + (size_t)(b * SEQ) * 1536 + h * 64;
        float q[64], acc[64];
        { const GAS v4u* qp = (const GAS v4u*)(base + (size_t)t * 1536);
#pragma unroll
          for (int j = 0; j < 8; ++j) unpack8(qp[j], q + 8 * j); }
#pragma unroll
        for (int j = 0; j < 64; ++j) acc[j] = 0.f;
        float between = 0.f;
        for (int s = t - 1; s >= 0; --s) {
            const GAS v4u* kp = (const GAS v4u*)(base + (size_t)s * 1536 + 512);
            const GAS v4u* vp = (const GAS v4u*)(base + (size_t)s * 1536 + 1024);
            float z = 0.f;
#pragma unroll
            for (int j = 0; j < 8; ++j) { float kf[8]; unpack8(kp[j], kf);
#pragma unroll
                for (int e = 0; e < 8; ++e) z += q[8 * j + e] * kf[e]; }
            const float lk = -(fmaxf(z, 0.f) + __logf(1.0f + __expf(-fabsf(z))));
            const float w = __expf(z + lk + between);
#pragma unroll
            for (int j = 0; j < 8; ++j) { float vf[8]; unpack8(vp[j], vf);
#pragma unroll
                for (int e = 0; e < 8; ++e) acc[8 * j + e] += w * vf[e]; }
            between += lk;
        }
        GAS v4u* op = (GAS v4u*)(O2 + (size_t)(b * SEQ + t) * 1024 + h * 64);
#pragma unroll
        for (int j = 0; j < 8; ++j) { v4u w; w.x = pk2(acc[8 * j], acc[8 * j + 1]); w.y = pk2(acc[8 * j + 2], acc[8 * j + 3]); w.z = pk2(acc[8 * j + 4], acc[8 * j + 5]); w.w = pk2(acc[8 * j + 6], acc[8 * j + 7]); op[j] = w; }
    }
}

__device__ __forceinline__ void ret_naive(Frame& F) {
    const bf16* RET = (const bf16*)(F.ws + WS_RET); bf16* O2 = (bf16*)(F.ws + WS_H);
    LAS float* red = (LAS float*)(F.lds + RING_OFF);
    for (int bh = blockIdx.x; bh < 32; bh += F.G) {
        const int b = bh >> 2, h = bh & 3;
        const float gamma = 1.0f - exp2f(-5.0f - (float)h);
        const int e = F.tid & 127, dg = F.tid >> 7;
        float S[32];
#pragma unroll
        for (int i = 0; i < 32; ++i) S[i] = 0.f;
        for (int t0 = 0; t0 < SEQ; t0 += 8) {
#pragma unroll 1
            for (int j = 0; j < 8; ++j) {
                const bf16* row = RET + (size_t)(b * SEQ + t0 + j) * 2048;
                const float vv = bf2f(row[1024 + h * 128 + e]);
                const GAS v4u* qp = (const GAS v4u*)(row + h * 128 + 32 * dg);
                const GAS v4u* kp = (const GAS v4u*)(row + 512 + h * 128 + 32 * dg);
                float p = 0.f;
#pragma unroll
                for (int c = 0; c < 4; ++c) { float qf[8], kf[8]; unpack8(qp[c], qf); unpack8(kp[c], kf);
#pragma unroll
                    for (int i = 0; i < 8; ++i) { S[8 * c + i] = gamma * S[8 * c + i] + kf[i] * vv; p += qf[i] * S[8 * c + i]; } }
                red[(j * 4 + dg) * 128 + e] = p;
            }
            __syncthreads();
            { const int j = F.wave; const bf16* row = RET + (size_t)(b * SEQ + t0 + j) * 2048;
              const float o0 = (red[(j * 4 + 0) * 128 + F.lane] + red[(j * 4 + 1) * 128 + F.lane]) + (red[(j * 4 + 2) * 128 + F.lane] + red[(j * 4 + 3) * 128 + F.lane]);
              const float o1 = (red[(j * 4 + 0) * 128 + 64 + F.lane] + red[(j * 4 + 1) * 128 + 64 + F.lane]) + (red[(j * 4 + 2) * 128 + 64 + F.lane] + red[(j * 4 + 3) * 128 + 64 + F.lane]);
              const float mean = wave_sum(o0 + o1) * (1.f / 128.f); const float d0 = o0 - mean, d1 = o1 - mean;
              const float var = wave_sum(d0 * d0 + d1 * d1) * (1.f / 128.f); const float rstd = 1.0f / sqrtf(var + GN_EPS);
              const float g0 = bf2f(row[1536 + h * 128 + F.lane]), g1 = bf2f(row[1536 + h * 128 + 64 + F.lane]);
              bf16* orow = O2 + (size_t)(b * SEQ + t0 + j) * 1024 + 512 + h * 128;
              orow[F.lane] = (bf16)f2bf(d0 * rstd * g0 * pg8::fast_sigmoid(g0)); orow[64 + F.lane] = (bf16)f2bf(d1 * rstd * g1 * pg8::fast_sigmoid(g1)); }
            __syncthreads();
        }
    }
}

struct Args { const float* in[17]; float* out; unsigned char* ws; int ph_lo, ph_hi, li, pad; };
__global__ void __launch_bounds__(NWAVES * 64, 2) skel_fwd(Args args) {
    extern __shared__ __attribute__((aligned(16))) unsigned char lds[];
    Frame F;
    F.lds = (LAS unsigned char*)lds;
    F.MISC = (volatile LAS unsigned*)(F.lds + MISC_OFF);
    F.tid = threadIdx.x; F.lane = F.tid & 63; F.wave = __builtin_amdgcn_readfirstlane(F.tid >> 6);
    F.G = gridDim.x; { const int bx = blockIdx.x; F.vcu = (F.G % 8 == 0) ? (bx % 8) * (F.G / 8) + bx / 8 : bx; }
#define GRID_BAR(seam) do { if (N_LAUNCHES == NPHASE) { if (F.tid == 0) __hip_atomic_store(F.ctl + CW_TMO, 0xBADBA0u | (unsigned)(seam), RLX_AGENT); } \
    else { xcd_barrier(bar); } } while (0)
    unsigned char* ws = args.ws; F.ws = ws;
    F.ctl = (gu32*)(ws + WS_CTL);
    F.x = args.in[0]; F.g_ffn1_pre = args.in[1]; F.g_ffn1_post = args.in[2]; F.w1g = args.in[3]; F.w1u = args.in[4]; F.w1d = args.in[5];
    F.g_mix_pre = args.in[6]; F.w_in = args.in[7]; F.w_psb = args.in[8]; F.w_pret = args.in[9]; F.w_out = args.in[10]; F.g_mix_post = args.in[11];
    F.g_ffn2_pre = args.in[12]; F.g_ffn2_post = args.in[13]; F.w2g = args.in[14]; F.w2u = args.in[15]; F.w2d = args.in[16]; F.out = args.out;
    for (int u = F.tid; u < (LDS_BYTES - LDSCTL_OFF) / 4; u += NWAVES * 64) ((LAS unsigned*)(F.lds + LDSCTL_OFF))[u] = 0u;
    __syncthreads();
    XcdBarrier bar; bar.bar = (unsigned*)(F.ctl + CW_BAR); bar.x = 0; bar.st = nullptr;
    if (N_LAUNCHES != NPHASE) bar = xcd_barrier_post((unsigned*)(F.ctl + CW_BAR), F.MISC + 8);

    const int lo = args.ph_lo, hi = args.ph_hi;
#define IN(k) (lo <= (k) && (k) < hi)
#define BOTH(k) (IN(k) && IN((k) + 1))
    bf16* H = (bf16*)(ws + WS_H);
    bf16* ACT = (bf16*)(ws + WS_ACT);

    if (IN(0)) { p0_prologue(F); if (BOTH(0)) GRID_BAR(0); }
    if (IN(1)) { pg8::Gemm g{H, (const bf16*)(ws + WS_WGU), M, 2 * FF, D}; pg8::StaticOrder S; S.init(M, 2 * FF, F.G, (int)blockIdx.x);
        pg8::EpiSwiGLU E{ACT, FF};
        pg8::gemm_phase<pg8::EpiSwiGLU, pg8::StaticOrder, true, true>(F.lds + RING_OFF, g, S, E);
        if (BOTH(1)) GRID_BAR(1); }
    if (IN(2)) { pg8::Gemm g{ACT, (const bf16*)(ws + WS_WD), M, D, FF}; pg8::StaticOrder S; S.init(M, D, F.G, (int)blockIdx.x);
        pg8::EpiF32 E{F.out, D};
        pg8::gemm_phase<pg8::EpiF32, pg8::StaticOrder, true, true>(F.lds + RING_OFF, g, S, E);
        if (BOTH(2)) GRID_BAR(2); }
    if (IN(3)) { rows_phase(F, F.out, F.x, F.out, F.g_ffn1_post, 0.5f, F.g_mix_pre, H);
        convert_ffn_weights(F, F.w2g, F.w2u, F.w2d, (LAS float*)(F.lds + RING_OFF + F.wave * 16384));
        if (BOTH(3)) GRID_BAR(3); }
    if (IN(4)) { pg8::Gemm g{H, (const bf16*)(ws + WS_WIN), M, NPROJ, D}; pg8::StaticOrder S; S.init(M, NPROJ, F.G, (int)blockIdx.x);
        pg8::EpiProj E{(bf16*)(ws + WS_QKVS), (bf16*)(ws + WS_RET), (bf16*)(ws + WS_GATES), (const float*)(ws + WS_ROPE), (const float*)(ws + WS_ROPE) + 2048 * 64};
        pg8::gemm_phase<pg8::EpiProj, pg8::StaticOrder, true, true>(F.lds + RING_OFF, g, S, E);
        if (BOTH(4)) GRID_BAR(4); }
    if (IN(5)) {
        const int R = (F.G >= 64) ? 32 : 0, bx = (int)blockIdx.x;
        if (R == 0 || bx < R) ret_naive(F);
        if (R == 0 || bx >= R) { const int na = F.G - R, a0 = bx - R;
            for (int u = a0; u < 512; u += na) sba::attn_unit(F.lds + RING_OFF, (const bf16*)(ws + WS_QKVS), H, u >> 6, (u >> 3) & 7, u & 7, F.tid, F.lane, F.wave); }
        if (BOTH(5)) GRID_BAR(5); }
    if (IN(6)) { pg8::Gemm g{H, (const bf16*)(ws + WS_WP), M, 2 * D, D}; pg8::StaticOrder S; S.init(M, 2 * D, F.G, (int)blockIdx.x);
        pg8::EpiMerge E{(bf16*)(ws + WS_MERGED), (const bf16*)(ws + WS_GATES)};
        pg8::gemm_phase<pg8::EpiMerge, pg8::StaticOrder, true, true>(F.lds + RING_OFF, g, S, E);
        if (BOTH(6)) GRID_BAR(6); }
    if (IN(7)) { pg8::Gemm g{(const bf16*)(ws + WS_MERGED), (const bf16*)(ws + WS_WOUT), M, D, D}; pg8::StaticOrder S; S.init(M, D, F.G, (int)blockIdx.x);
        pg8::EpiF32 E{(float*)(ws + WS_Z), D};
        pg8::gemm_phase<pg8::EpiF32, pg8::StaticOrder, true, true>(F.lds + RING_OFF, g, S, E);
        if (BOTH(7)) GRID_BAR(7); }
    if (IN(8)) { rows_phase(F, (const float*)(ws + WS_Z), F.out, F.out, F.g_mix_post, 1.0f, F.g_ffn2_pre, H); if (BOTH(8)) GRID_BAR(8); }
    if (IN(9)) { pg8::Gemm g{H, (const bf16*)(ws + WS_WGU), M, 2 * FF, D}; pg8::StaticOrder S; S.init(M, 2 * FF, F.G, (int)blockIdx.x);
        pg8::EpiSwiGLU E{ACT, FF};
        pg8::gemm_phase<pg8::EpiSwiGLU, pg8::StaticOrder, true, true>(F.lds + RING_OFF, g, S, E);
        if (BOTH(9)) GRID_BAR(9); }
    if (IN(10)) { pg8::Gemm g{ACT, (const bf16*)(ws + WS_WD), M, D, FF}; pg8::StaticOrder S; S.init(M, D, F.G, (int)blockIdx.x);
        pg8::EpiF32 E{(float*)(ws + WS_Y2), D};
        pg8::gemm_phase<pg8::EpiF32, pg8::StaticOrder, true, true>(F.lds + RING_OFF, g, S, E);
        if (BOTH(10)) GRID_BAR(10); }
    if (IN(11)) { rows_phase(F, (const float*)(ws + WS_Y2), F.out, F.out, F.g_ffn2_post, 0.5f, nullptr, nullptr); }
#undef IN
#undef BOTH
}

extern "C" void kernel_launch(void* const* d_in, const int* in_sizes, int n_in, void* d_out, int out_size, void* d_ws, size_t ws_size, hipStream_t stream) {
    static int grid = 0;
    if (grid == 0) {
        if (n_in != 17 || in_sizes[0] != M * D || out_size != M * D || ws_size < WS_END) { fprintf(stderr, "kernel_launch: unexpected shapes: n_in %d in0 %d out %d ws %zu (need %zu)\n", n_in, n_in > 0 ? in_sizes[0] : -1, out_size, ws_size, (size_t)WS_END); grid = -1; return; }
        int dev = 0, cus = 0, per_cu = 0;
        if (hipGetDevice(&dev) != hipSuccess || hipDeviceGetAttribute(&cus, hipDeviceAttributeMultiprocessorCount, dev) != hipSuccess) { fprintf(stderr, "kernel_launch: device query failed\n"); grid = -1; return; }
        if (hipFuncSetAttribute((const void*)skel_fwd, hipFuncAttributeMaxDynamicSharedMemorySize, LDS_BYTES) != hipSuccess) { fprintf(stderr, "kernel_launch: hipFuncSetAttribute failed\n"); grid = -1; return; }
        if (hipOccupancyMaxActiveBlocksPerMultiprocessor(&per_cu, (const void*)skel_fwd, NWAVES * 64, LDS_BYTES) != hipSuccess || per_cu < 1)
            fprintf(stderr, "kernel_launch: note: occupancy query reports %d workgroups per CU\n", per_cu);
        (void)hipGetLastError();
        grid = cus;
        if (grid > 256) grid = 256;
    }
    if (grid < 0) return;
    if (hipMemsetAsync((char*)d_ws + WS_CTL, 0, CTL_ZERO_BYTES, stream) != hipSuccess) { fprintf(stderr, "kernel_launch: memset failed\n"); return; }
    Args a{};
    for (int i = 0; i < 17; ++i) a.in[i] = (const float*)d_in[i];
    a.out = (float*)d_out; a.ws = (unsigned char*)d_ws;
    for (int li = 0; li < N_LAUNCHES; ++li) {
        a.ph_lo = (N_LAUNCHES == NPHASE) ? li : 0; a.ph_hi = (N_LAUNCHES == NPHASE) ? li + 1 : NPHASE; a.li = li;
        hipLaunchKernelGGL(skel_fwd, dim3(grid), dim3(NWAVES * 64), LDS_BYTES, stream, a);
        const hipError_t le = hipPeekAtLastError();
        if (le != hipSuccess) { fprintf(stderr, "kernel_launch: launch %d failed: %s\n", li, hipGetErrorName(le)); break; }
    }
}
```

```cpp
#include <hip/hip_runtime.h>
#include <cstdio>
#include <cstdint>
#include <cmath>
namespace pg8 {
#define PG8_LAS __attribute__((address_space(3)))
typedef unsigned short bf16_t;
typedef short bf16x8 __attribute__((ext_vector_type(8)));
typedef float f32x4 __attribute__((ext_vector_type(4)));
typedef unsigned u32x4 __attribute__((ext_vector_type(4)));
constexpr int BM = 256, BK = 64, HALF = 128, HTB = HALF * BK * 2  , STAGE_BYTES = 8 * HTB, NXCD = 8, WGM = 8;

__host__ __device__ __forceinline__ int lds_byte(int r, int c) { const int st = (r >> 4) * 2 + (c >> 5), rr = r & 15, cc = c & 31, ob = rr * 64 + cc * 2; return st * 1024 + (ob ^ (((ob >> 9) & 1) << 5)); }
__host__ __device__ __forceinline__ void stage_rc(int b, int& R, int& C) { const int st = b / 1024, sb = b % 1024, swz = sb ^ (((sb >> 9) & 1) << 5); R = (st >> 1) * 16 + swz / 64; C = (st & 1) * 32 + (swz % 64) / 2; }
__host__ __device__ __forceinline__ int perm32(int rho) { const int n = rho >> 4, i = rho & 15; return 8 * (i >> 2) + 4 * n + (i & 3); }

struct Unit { int pm, pn; };
struct Gemm { const bf16_t* A; const bf16_t* Bt; int M, N, K; };

struct StaticOrder {
    int nM, nN, nwg, G, c;
    __host__ __device__ void init(int M, int N, int G_, int c_) { nM = M / BM; nN = N / BM; nwg = nM * nN; G = G_; c = c_; }
    __host__ __device__ bool next(int i, Unit& u) const {
        const long L = (long)i * G + c; if (L >= nwg) return false;
        int wgid = (int)L; { const int q = nwg / NXCD, r = nwg % NXCD, xcd = wgid % NXCD, off = wgid / NXCD; wgid = (xcd < r ? xcd * (q + 1) : r * (q + 1) + (xcd - r) * q) + off; }
        const int nig = WGM * nN, gid = wgid / nig, fm = gid * WGM, gsz = (nM - fm) < WGM ? (nM - fm) : WGM;
        u.pm = fm + ((wgid % nig) % gsz); u.pn = (wgid % nig) / gsz; return true;
    }
    __device__ __forceinline__ void a_ready(const Unit&) const {}
    __device__ __forceinline__ void done(const Unit&) const {}
};

__device__ __forceinline__ unsigned cvt_pk_bf16(float lo, float hi) { unsigned r; asm volatile("v_cvt_pk_bf16_f32 %0, %1, %2" : "=v"(r) : "v"(lo), "v"(hi)); return r; }
typedef float f32x2 __attribute__((ext_vector_type(2)));

__device__ __forceinline__ float fast_sigmoid(float x) { return __builtin_amdgcn_rcpf(1.0f + __expf(-x)); }
__device__ __forceinline__ float bf_lo(unsigned w) { return __uint_as_float(w << 16); }
__device__ __forceinline__ float bf_hi(unsigned w) { return __uint_as_float(w & 0xffff0000u); }

struct EpiSwiGLU {
    static constexpr bool PERM = true, AFTER_DRAIN = false;
    bf16_t* O; int ldc;
    __device__ __forceinline__ void operator()(const f32x4 (&acc)[2][2][4][2], const Unit& u, int wr, int wc, int fr, int fq) const {
        const int row0 = u.pm * BM + wr * 64 + fr, col0 = u.pn * HALF + wc * 32 + 8 * fq;
#pragma unroll
        for (int ai = 0; ai < 2; ++ai)
#pragma unroll
            for (int m = 0; m < 4; ++m) {
                bf16_t* rowp = O + (size_t)(row0 + ai * HALF + m * 16) * ldc + col0;
                float v[8];
#pragma unroll
                for (int n = 0; n < 2; ++n)
#pragma unroll
                    for (int e = 0; e < 4; ++e) { const float g = acc[ai][0][m][n][e], up = acc[ai][1][m][n][e]; v[4 * n + e] = g * fast_sigmoid(g) * up; }
                u32x4 w; w.x = cvt_pk_bf16(v[0], v[1]); w.y = cvt_pk_bf16(v[2], v[3]); w.z = cvt_pk_bf16(v[4], v[5]); w.w = cvt_pk_bf16(v[6], v[7]);
                *(u32x4*)rowp = w;
            }
    }
};

struct EpiF32 {
    static constexpr bool PERM = false, AFTER_DRAIN = false;
    float* O; int ldc;
    __device__ __forceinline__ void operator()(const f32x4 (&acc)[2][2][4][2], const Unit& u, int wr, int wc, int fr, int fq) const {
        const int row0 = u.pm * BM + wr * 64 + fr, col0 = u.pn * BM + wc * 32 + 4 * fq;
#pragma unroll
        for (int ai = 0; ai < 2; ++ai)
#pragma unroll
            for (int m = 0; m < 4; ++m) {
                float* rowp = O + (size_t)(row0 + ai * HALF + m * 16) * ldc + col0;
#pragma unroll
                for (int bj = 0; bj < 2; ++bj)
#pragma unroll
                    for (int n = 0; n < 2; ++n) *(f32x4*)(rowp + bj * HALF + n * 16) = acc[ai][bj][m][n];
            }
    }
};

struct EpiProj {
    static constexpr bool PERM = true, AFTER_DRAIN = false;
    bf16_t* QKVS; bf16_t* RET; bf16_t* GATES; const float* ropec; const float* ropes;
    __device__ __forceinline__ void operator()(const f32x4 (&acc)[2][2][4][2], const Unit& u, int wr, int wc, int fr, int fq) const {
        const int row0 = u.pm * BM + wr * 64 + fr; const int pn = u.pn;
        if (pn >= 6 && pn < 10) {
            const float sc = (pn >= 8) ? 0.08838834764831845f : 1.0f;
            const int hl = wc >> 1, i0 = 32 * (wc & 1) + 8 * fq;
            const int colb = (pn - 6) * BM + hl * 128 + i0;
#pragma unroll
            for (int ai = 0; ai < 2; ++ai)
#pragma unroll
                for (int m = 0; m < 4; ++m) {
                    const int row = row0 + ai * HALF + m * 16; const int pos = row & 2047;
                    const f32x4 c0 = *(const f32x4*)(ropec + pos * 64 + i0), c1 = *(const f32x4*)(ropec + pos * 64 + i0 + 4);
                    const f32x4 s0 = *(const f32x4*)(ropes + pos * 64 + i0), s1 = *(const f32x4*)(ropes + pos * 64 + i0 + 4);
                    float o1[8], o2[8];
#pragma unroll
                    for (int n = 0; n < 2; ++n)
#pragma unroll
                        for (int e = 0; e < 4; ++e) { const float x1 = acc[ai][0][m][n][e], x2 = acc[ai][1][m][n][e]; const float c = n ? c1[e] : c0[e], s = n ? s1[e] : s0[e];
                            o1[4 * n + e] = (x1 * c - x2 * s) * sc; o2[4 * n + e] = (x1 * s + x2 * c) * sc; }
                    bf16_t* rowp = RET + (size_t)row * 2048 + colb;
                    u32x4 w; w.x = cvt_pk_bf16(o1[0], o1[1]); w.y = cvt_pk_bf16(o1[2], o1[3]); w.z = cvt_pk_bf16(o1[4], o1[5]); w.w = cvt_pk_bf16(o1[6], o1[7]);
                    *(u32x4*)rowp = w;
                    w.x = cvt_pk_bf16(o2[0], o2[1]); w.y = cvt_pk_bf16(o2[2], o2[3]); w.z = cvt_pk_bf16(o2[4], o2[5]); w.w = cvt_pk_bf16(o2[6], o2[7]);
                    *(u32x4*)(rowp + 64) = w;
                }
            return;
        }
        bf16_t* base; int ldc, colt; float sc = 1.0f;
        if (pn < 6) { base = QKVS; ldc = 1536; colt = pn * BM; if (pn < 2) sc = 0.125f * 1.4426950408889634f; }
        else if (pn < 14) { base = RET; ldc = 2048; colt = (pn - 6) * BM; }
        else { base = GATES; ldc = 2048; colt = (pn - 14) * BM; }
        const int col0 = colt + wc * 32 + 8 * fq;
#pragma unroll
        for (int ai = 0; ai < 2; ++ai)
#pragma unroll
            for (int m = 0; m < 4; ++m) { bf16_t* rowp = base + (size_t)(row0 + ai * HALF + m * 16) * ldc + col0;
#pragma unroll
                for (int bj = 0; bj < 2; ++bj) { const f32x4 v0 = acc[ai][bj][m][0] * sc, v1 = acc[ai][bj][m][1] * sc;
                    u32x4 w; w.x = cvt_pk_bf16(v0[0], v0[1]); w.y = cvt_pk_bf16(v0[2], v0[3]); w.z = cvt_pk_bf16(v1[0], v1[1]); w.w = cvt_pk_bf16(v1[2], v1[3]);
                    *(u32x4*)(rowp + bj * HALF) = w; } }
    }
};

struct EpiMerge {
    static constexpr bool PERM = true, AFTER_DRAIN = false;
    bf16_t* O; const bf16_t* GATES;
    __device__ __forceinline__ void operator()(const f32x4 (&acc)[2][2][4][2], const Unit& u, int wr, int wc, int fr, int fq) const {
        const int row0 = u.pm * BM + wr * 64 + fr, col0 = u.pn * HALF + wc * 32 + 8 * fq;
#pragma unroll
        for (int ai = 0; ai < 2; ++ai)
#pragma unroll
            for (int m = 0; m < 4; ++m) {
                const size_t row = (size_t)(row0 + ai * HALF + m * 16);
                const u32x4 ga = *(const u32x4*)(GATES + row * 2048 + col0), gb = *(const u32x4*)(GATES + row * 2048 + 1024 + col0);
                float a[8], b[8];
                a[0] = bf_lo(ga.x); a[1] = bf_hi(ga.x); a[2] = bf_lo(ga.y); a[3] = bf_hi(ga.y); a[4] = bf_lo(ga.z); a[5] = bf_hi(ga.z); a[6] = bf_lo(ga.w); a[7] = bf_hi(ga.w);
                b[0] = bf_lo(gb.x); b[1] = bf_hi(gb.x); b[2] = bf_lo(gb.y); b[3] = bf_hi(gb.y); b[4] = bf_lo(gb.z); b[5] = bf_hi(gb.z); b[6] = bf_lo(gb.w); b[7] = bf_hi(gb.w);
                float v[8];
#pragma unroll
                for (int n = 0; n < 2; ++n)
#pragma unroll
                    for (int e = 0; e < 4; ++e) v[4 * n + e] = fast_sigmoid(a[4 * n + e]) * acc[ai][0][m][n][e] + fast_sigmoid(b[4 * n + e]) * acc[ai][1][m][n][e];
                u32x4 w; w.x = cvt_pk_bf16(v[0], v[1]); w.y = cvt_pk_bf16(v[2], v[3]); w.z = cvt_pk_bf16(v[4], v[5]); w.w = cvt_pk_bf16(v[6], v[7]);
                *(u32x4*)(O + row * 1024 + col0) = w;
            }
    }
};
template <class Epi, class Sched, bool ALIGN_EPI = false, bool SP2 = false>
__device__ __forceinline__ void gemm_phase(PG8_LAS unsigned char* lds, const Gemm g, const Sched& S, const Epi& E) {
    const int tid = threadIdx.x, wid = __builtin_amdgcn_readfirstlane(tid >> 6), lane = tid & 63, wr = wid >> 2, wc = wid & 3, fr = lane & 15, fq = lane >> 4;
    const int K = g.K, nt = K / BK;
    unsigned voffA[2], voffB[2];
#pragma unroll
    for (int i = 0; i < 2; ++i) { int R, C; stage_rc(tid * 16 + i * 8192, R, C); const int Rb = Epi::PERM ? ((R & ~31) + perm32(R & 31)) : R;
        voffA[i] = (unsigned)(R * K + C) * 2u; voffB[i] = (unsigned)(Rb * K + C) * 2u; }
    const size_t kstep = (size_t)(BK * 2);
    const size_t hstep = (size_t)HALF * K * 2;
    const size_t tstep = 2 * hstep;
    const unsigned ldsw = (unsigned)wid * 1024u;
    const int aoff = lds_byte(wr * 64 + fr, fq * 8), boff = lds_byte(wc * 32 + fr, fq * 8);
#define PG8_SA(b, h) (((b) * 2 + (h)) * HTB)
#define PG8_SB(b, h) ((4 + (b) * 2 + (h)) * HTB)
#define PG8_STAGE(bufoff, gbase, voff) do { _Pragma("unroll") for (int _i = 0; _i < 2; ++_i) \
        __builtin_amdgcn_global_load_lds((const unsigned*)((const char*)(gbase) + (voff)[_i]), (PG8_LAS unsigned*)(lds + (bufoff) + ldsw + _i * 8192), 16, 0, 0); } while (0)
#define PG8_LDA(dst, b, h) do { _Pragma("unroll") for (int m = 0; m < 4; ++m) _Pragma("unroll") for (int k = 0; k < 2; ++k) dst[m][k] = *(const PG8_LAS bf16x8*)(lds + PG8_SA(b, h) + aoff + m * 2048 + k * 1024); } while (0)
#define PG8_LDB(dst, b, h) do { _Pragma("unroll") for (int n = 0; n < 2; ++n) _Pragma("unroll") for (int k = 0; k < 2; ++k) dst[n][k] = *(const PG8_LAS bf16x8*)(lds + PG8_SB(b, h) + boff + n * 2048 + k * 1024); } while (0)
#define PG8_MMA(ai, bj, At, Bt) do { __builtin_amdgcn_s_setprio(1); _Pragma("unroll") for (int m = 0; m < 4; ++m) _Pragma("unroll") for (int n = 0; n < 2; ++n) _Pragma("unroll") for (int k = 0; k < 2; ++k) \
        acc[ai][bj][m][n] = __builtin_amdgcn_mfma_f32_16x16x32_bf16(Bt[n][k], At[m][k], acc[ai][bj][m][n], 0, 0, 0); __builtin_amdgcn_s_setprio(0); } while (0)
#define PG8_WAIT_V(n) asm volatile("s_waitcnt vmcnt(" #n ")" ::: "memory")
#define PG8_WAIT_L(n) asm volatile("s_waitcnt lgkmcnt(" #n ")" ::: "memory")
#define PG8_BAR __builtin_amdgcn_s_barrier()
#define PG8_SCHED __builtin_amdgcn_sched_barrier(0)
    Unit cur, nxt; int ui = 0;
    if (!S.next(0, cur)) return;
    f32x4 acc[2][2][4][2];
#pragma unroll
    for (int a = 0; a < 2; ++a)
#pragma unroll
        for (int b = 0; b < 2; ++b)
#pragma unroll
            for (int m = 0; m < 4; ++m)
#pragma unroll
                for (int n = 0; n < 2; ++n) acc[a][b][m][n] = (f32x4){0.f, 0.f, 0.f, 0.f};
    bf16x8 At[4][2], B0[2][2], B1[2][2];
    const char* cA = (const char*)g.A + (size_t)cur.pm * tstep; const char* cB = (const char*)g.Bt + (size_t)cur.pn * tstep;
    S.a_ready(cur);
    if constexpr (SP2) {
        PG8_STAGE(PG8_SB(0, 0), cB, voffB); PG8_STAGE(PG8_SB(0, 1), cB + hstep, voffB); PG8_STAGE(PG8_SA(0, 0), cA, voffA); PG8_STAGE(PG8_SA(0, 1), cA + hstep, voffA);
        if (wr == 1) PG8_BAR;
        PG8_WAIT_V(2); PG8_BAR;
        PG8_STAGE(PG8_SB(1, 0), cB + kstep, voffB); PG8_STAGE(PG8_SA(1, 0), cA + kstep, voffA); PG8_STAGE(PG8_SB(1, 1), cB + hstep + kstep, voffB);
        PG8_WAIT_V(6); PG8_BAR;
    } else {
        PG8_STAGE(PG8_SB(0, 0), cB, voffB); PG8_STAGE(PG8_SA(0, 0), cA, voffA); PG8_STAGE(PG8_SB(0, 1), cB + hstep, voffB); PG8_STAGE(PG8_SA(0, 1), cA + hstep, voffA);
        if (wr == 1) PG8_BAR;
        PG8_WAIT_V(4); PG8_BAR;
        PG8_STAGE(PG8_SB(1, 0), cB + kstep, voffB); PG8_STAGE(PG8_SA(1, 0), cA + kstep, voffA); PG8_STAGE(PG8_SB(1, 1), cB + hstep + kstep, voffB);
        PG8_WAIT_V(6); PG8_BAR;
    }
    for (;;) {
        const bool has_next = S.next(ui + 1, nxt);
        const char* nA = has_next ? (const char*)g.A + (size_t)nxt.pm * tstep : cA; const char* nB = has_next ? (const char*)g.Bt + (size_t)nxt.pn * tstep : cB;
        for (int t = 0; t < nt; t += 2) {
            const bool last = (t == nt - 2);
            const char* a1 = cA + (size_t)(t + 1) * kstep;
            const char* a2 = last ? nA : cA + (size_t)(t + 2) * kstep; const char* b2 = last ? nB : cB + (size_t)(t + 2) * kstep;
            const char* a3 = a2 + kstep; const char* b3 = b2 + kstep;
            if (last && has_next) S.a_ready(nxt);
            if constexpr (SP2) {
            PG8_LDB(B0, 0, 0); PG8_LDB(B1, 0, 1); PG8_SCHED; PG8_LDA(At, 0, 0); PG8_STAGE(PG8_SA(1, 1), a1 + hstep, voffA);
            PG8_WAIT_V(8); PG8_WAIT_L(0); PG8_BAR; PG8_MMA(0, 0, At, B0); PG8_MMA(0, 1, At, B1); PG8_BAR; PG8_SCHED;
            PG8_LDA(At, 0, 1); PG8_STAGE(PG8_SB(0, 0), b2, voffB); PG8_STAGE(PG8_SB(0, 1), b2 + hstep, voffB); PG8_STAGE(PG8_SA(0, 0), a2, voffA);
            PG8_WAIT_V(8); PG8_WAIT_L(0); PG8_BAR; PG8_MMA(1, 0, At, B0); PG8_MMA(1, 1, At, B1); PG8_BAR; PG8_SCHED;
            PG8_LDB(B0, 1, 0); PG8_LDB(B1, 1, 1); PG8_SCHED; PG8_LDA(At, 1, 0); PG8_STAGE(PG8_SA(0, 1), a2 + hstep, voffA);
            PG8_WAIT_V(8); PG8_WAIT_L(0); PG8_BAR; PG8_MMA(0, 0, At, B0); PG8_MMA(0, 1, At, B1); PG8_BAR; PG8_SCHED;
            PG8_LDA(At, 1, 1); PG8_STAGE(PG8_SB(1, 0), b3, voffB); PG8_STAGE(PG8_SB(1, 1), b3 + hstep, voffB); PG8_STAGE(PG8_SA(1, 0), a3, voffA);
            PG8_WAIT_V(8); PG8_WAIT_L(0); PG8_BAR; PG8_MMA(1, 0, At, B0); PG8_MMA(1, 1, At, B1); PG8_BAR; PG8_SCHED;
            } else {
            PG8_LDB(B0, 0, 0); PG8_SCHED; PG8_LDA(At, 0, 0); PG8_STAGE(PG8_SA(1, 1), a1 + hstep, voffA);
            PG8_WAIT_L(8); PG8_BAR; PG8_WAIT_L(0); PG8_MMA(0, 0, At, B0); PG8_BAR; PG8_SCHED;
            PG8_LDB(B1, 0, 1); PG8_STAGE(PG8_SB(0, 0), b2, voffB);
            PG8_BAR; PG8_WAIT_L(0); PG8_MMA(0, 1, At, B1); PG8_BAR;
            PG8_LDA(At, 0, 1); PG8_STAGE(PG8_SA(0, 0), a2, voffA);
            PG8_BAR; PG8_WAIT_L(0); PG8_MMA(1, 0, At, B0); PG8_BAR; PG8_SCHED;
            PG8_STAGE(PG8_SB(0, 1), b2 + hstep, voffB);
            PG8_WAIT_V(6); PG8_BAR; PG8_MMA(1, 1, At, B1); PG8_BAR;
            PG8_LDB(B0, 1, 0); PG8_SCHED; PG8_LDA(At, 1, 0); PG8_STAGE(PG8_SA(0, 1), a2 + hstep, voffA);
            PG8_WAIT_L(8); PG8_BAR; PG8_WAIT_L(0); PG8_MMA(0, 0, At, B0); PG8_BAR; PG8_SCHED;
            PG8_LDB(B1, 1, 1); PG8_STAGE(PG8_SB(1, 0), b3, voffB);
            PG8_BAR; PG8_WAIT_L(0); PG8_MMA(0, 1, At, B1); PG8_BAR;
            PG8_LDA(At, 1, 1); PG8_STAGE(PG8_SA(1, 0), a3, voffA);
            PG8_BAR; PG8_WAIT_L(0); PG8_MMA(1, 0, At, B0); PG8_BAR; PG8_SCHED;
            PG8_STAGE(PG8_SB(1, 1), b3 + hstep, voffB);
            PG8_WAIT_V(6); PG8_BAR; PG8_MMA(1, 1, At, B1); PG8_BAR;
            }
        }
        if constexpr (ALIGN_EPI) { if (wr == 0) PG8_BAR; }
        if constexpr (!Epi::AFTER_DRAIN) { E(acc, cur, wr, wc, fr, fq); S.done(cur); }
        if (!has_next) break;
#pragma unroll
        for (int a = 0; a < 2; ++a)
#pragma unroll
            for (int b = 0; b < 2; ++b)
#pragma unroll
                for (int m = 0; m < 4; ++m)
#pragma unroll
                    for (int n = 0; n < 2; ++n) acc[a][b][m][n] = (f32x4){0.f, 0.f, 0.f, 0.f};
        cur = nxt; cA = nA; cB = nB; ++ui;
        if constexpr (ALIGN_EPI) { if (wr == 1) PG8_BAR; }
    }
    PG8_WAIT_V(0);
    if constexpr (!ALIGN_EPI) { if (wr == 0) PG8_BAR; }
    PG8_BAR;
    if constexpr (Epi::AFTER_DRAIN) { E.fused(acc, cur, wr, wc, fr, fq, lds, wid, lane); S.done(cur); }
#undef PG8_SA
#undef PG8_SB
#undef PG8_STAGE
#undef PG8_LDA
#undef PG8_LDB
#undef PG8_MMA
#undef PG8_WAIT_V
#undef PG8_WAIT_L
#undef PG8_BAR
#undef PG8_SCHED
}
}
#define GAS __attribute__((address_space(1)))
#define LAS __attribute__((address_space(3)))
typedef unsigned short bf16;
typedef unsigned v4u __attribute__((ext_vector_type(4)));
typedef float f32x4 __attribute__((ext_vector_type(4)));
typedef short bf16x8 __attribute__((ext_vector_type(8)));
typedef GAS unsigned gu32;
typedef GAS unsigned long long gu64;
#define RLX_AGENT __ATOMIC_RELAXED, __HIP_MEMORY_SCOPE_AGENT
#define LDS_WAIT() asm volatile("s_waitcnt lgkmcnt(0)" ::: "memory")
#define VM_WAIT() asm volatile("s_waitcnt vmcnt(0)" ::: "memory")
__device__ __forceinline__ unsigned long long rt() { return __builtin_amdgcn_s_memrealtime(); }
__device__ __forceinline__ unsigned f2bf(float f) { unsigned u = __builtin_bit_cast(unsigned, f); return (u + 0x7fffu + ((u >> 16) & 1u)) >> 16; }
__device__ __forceinline__ unsigned pk2(float lo, float hi) { return f2bf(lo) | (f2bf(hi) << 16); }

#define XB_TMO      128
#define XB_XCNT(j)  (256  + 64 * (j))
#define XB_XSUB(j)  (1280 + 64 * (j))
#define XB_XGEN(j)  (2304 + 64 * (j))
#define XB_TOP      3328
#define XB_TOPGEN   3392
#define XCD_BAR_WORDS 3456
#define XB_SPIN_CAP (1u << 18)

__device__ __forceinline__ unsigned xb_ld(unsigned* p)              { return __hip_atomic_load(p, __ATOMIC_RELAXED, __HIP_MEMORY_SCOPE_AGENT); }
__device__ __forceinline__ unsigned xb_add(unsigned* p, unsigned v) { return __hip_atomic_fetch_add(p, v, __ATOMIC_RELAXED, __HIP_MEMORY_SCOPE_AGENT); }
__device__ __forceinline__ unsigned xb_xcc_id() { return (unsigned)__builtin_amdgcn_s_getreg((3 << 11) | 20) & 0xFu; }
#define XB_SPIN(cond, bar) do { unsigned _sp = 0; while (cond) { __builtin_amdgcn_s_sleep(1); \
    if ((++_sp & 255u) == 0u) { if (xb_ld(&(bar)[XB_TMO])) break; if (_sp > XB_SPIN_CAP) { atomicAdd(&(bar)[XB_TMO], 1u); break; } } } } while (0)

struct XcdBarrier {
    unsigned* bar; unsigned x;
    volatile LAS unsigned* st;
};

__device__ __forceinline__ XcdBarrier xcd_barrier_post(unsigned* bar, volatile LAS unsigned* st) {
    XcdBarrier b; b.bar = bar; b.x = xb_xcc_id(); b.st = st;
    if (threadIdx.x == 0) (void)xb_add(&bar[XB_XCNT(b.x)], 1u);
    return b;
}
__device__ __forceinline__ void xcd_barrier_complete(unsigned* bar, unsigned x, unsigned& nloc, unsigned& nx) {
    const unsigned G = gridDim.x * gridDim.y * gridDim.z;
    unsigned sum, cnt, mine, sp = 0u;
    for (;;) {
        sum = 0u; cnt = 0u; mine = 0u;
#pragma unroll
        for (unsigned j = 0; j < 16; ++j) { const unsigned c = xb_ld(&bar[XB_XCNT(j)]); sum += c; cnt += (c > 0u) ? 1u : 0u; mine = (j == x) ? c : mine; }
        if (sum == G) break;
        __builtin_amdgcn_s_sleep(1);
        if ((++sp & 255u) == 0u) { if (xb_ld(&bar[XB_TMO])) break; if (sp > XB_SPIN_CAP) { atomicAdd(&bar[XB_TMO], 1u); break; } }
    }
    nloc = mine > 0u ? mine : 1u; nx = cnt > 0u ? cnt : 1u;
}

__device__ __forceinline__ void xcd_barrier(const XcdBarrier& b) {
    asm volatile("s_waitcnt vmcnt(0)" ::: "memory");
    __syncthreads();
    if (threadIdx.x == 0) {
        unsigned* bar = b.bar;
        __builtin_amdgcn_s_waitcnt(0);
        unsigned nloc = b.st[0], nx = b.st[1];
        if (nloc == 0u) { xcd_barrier_complete(bar, b.x, nloc, nx); b.st[0] = nloc; b.st[1] = nx; }
        const unsigned old = xb_add(&bar[XB_XSUB(b.x)], 1u);
        const unsigned gen = old / nloc;
        if (old + 1u == (gen + 1u) * nloc) {
            __builtin_amdgcn_fence(__ATOMIC_RELEASE, "agent");
            asm volatile("s_waitcnt vmcnt(0)" ::: "memory");
            const unsigned og = xb_add(&bar[XB_TOP], 1u);
            const unsigned tg = og / nx;
            if (og + 1u == (tg + 1u) * nx) xb_add(&bar[XB_TOPGEN], 1u);
            else XB_SPIN(xb_ld(&bar[XB_TOPGEN]) == tg, bar);
            __builtin_amdgcn_fence(__ATOMIC_ACQUIRE, "agent");
            xb_add(&bar[XB_XGEN(b.x)], 1u);
            asm volatile("s_waitcnt vmcnt(0)" ::: "memory");
        } else {
            XB_SPIN(xb_ld(&bar[XB_XGEN(b.x)]) == gen, bar);
            __builtin_amdgcn_fence(__ATOMIC_ACQUIRE, "agent");
            asm volatile("s_waitcnt vmcnt(0)" ::: "memory");
        }
    }
    __syncthreads();
}

constexpr int NWAVES = 8;
#ifndef MK_N_LAUNCHES
#define MK_N_LAUNCHES 1
#endif
constexpr int N_LAUNCHES = MK_N_LAUNCHES;
constexpr int NPHASE = 12;
constexpr int BATCH = 8, SEQ = 2048, D = 1024, FF = 4096, M = BATCH * SEQ;
constexpr int NPROJ = 5632;
constexpr float RMS_EPS = 1e-6f, GN_EPS = 1e-5f;

constexpr size_t MiB = 1u << 20;
constexpr size_t WS_CTL = 0, CTL_ZERO_BYTES = 1 * MiB;
constexpr size_t WS_ROPE = 1 * MiB;
constexpr size_t WS_WD = 2 * MiB;
constexpr size_t WS_H = 10 * MiB;
constexpr size_t WS_WIN = 42 * MiB;
constexpr size_t WS_WP = 53 * MiB;
constexpr size_t WS_WOUT = 57 * MiB;
constexpr size_t WS_WGU = 59 * MiB;
constexpr size_t WS_Y2 = 10 * MiB;
constexpr size_t WS_BIG = 75 * MiB;
constexpr size_t WS_ACT = WS_BIG;
constexpr size_t WS_QKVS = WS_BIG;
constexpr size_t WS_RET = WS_BIG + 48 * MiB;
constexpr size_t WS_GATES = WS_BIG + 112 * MiB;
constexpr size_t WS_MERGED = WS_BIG;
constexpr size_t WS_Z = WS_BIG + 48 * MiB;
constexpr size_t WS_END = 251 * MiB;
static_assert(WS_Y2 + (size_t)M * D * 4 <= WS_BIG && WS_GATES + (size_t)M * 2048 * 2 <= WS_END && WS_WGU + (size_t)8192 * 1024 * 2 <= WS_BIG, "ws map");
constexpr int CW_TMO = 0, CW_CODE = 1;
constexpr int CW_BAR = 4096;

constexpr int RING_OFF = 0, RING_BYTES = 131072;
constexpr int LDSCTL_OFF = RING_BYTES, MISC_OFF = LDSCTL_OFF + 320;
constexpr int LDS_BYTES = 147456;

__device__ __forceinline__ float wave_sum(float v) {
#pragma unroll
    for (int o = 1; o < 64; o <<= 1) v += __shfl_xor(v, o);
    return v;
}

namespace sba {
typedef float f32x16 __attribute__((ext_vector_type(16)));
typedef short s16x4 __attribute__((ext_vector_type(4)));
typedef short v4i16_t __attribute__((ext_vector_type(4)));
constexpr int KPITCH = 144, KBUF = 64 * KPITCH, VBUF = 8192, BUFSZ = KBUF + VBUF, FLAG_OFF = 2 * BUFSZ, OST_OFF = FLAG_OFF + 64;
constexpr float A_DONE = 150.0f;
__device__ __forceinline__ int crow(int r, int hi) { return (r & 3) + 8 * (r >> 2) + 4 * hi; }
__device__ __forceinline__ s16x4 vtr(const LAS unsigned char* p) { return __builtin_bit_cast(s16x4, __builtin_amdgcn_ds_read_tr16_b64_v4i16((LAS v4i16_t*)p)); }
__device__ __forceinline__ unsigned cvtpk(float lo, float hi) { unsigned r; asm volatile("v_cvt_pk_bf16_f32 %0, %1, %2" : "=v"(r) : "v"(lo), "v"(hi)); return r; }

__device__ __forceinline__ void attn_unit(LAS unsigned char* lds, const bf16* QKVS, bf16* O2, int b, int h, int qb, int tid, int lane, int wave) {
    const int r32 = lane & 31, hi = lane >> 5;
    const int q0w = 256 * qb + 32 * wave;
    const size_t rowbase = (size_t)b * SEQ;
    bf16x8 qf[4];
#pragma unroll
    for (int ks = 0; ks < 4; ++ks) qf[ks] = *(const GAS bf16x8*)(QKVS + (rowbase + q0w + r32) * 1536 + h * 64 + 16 * ks + 8 * hi);
    f32x16 o0, o1;
#pragma unroll
    for (int i = 0; i < 16; ++i) { o0[i] = 0.f; o1[i] = 0.f; }
    float carry = 0.f;
    const int Ttop = 4 * qb + 3, wstart = 4 * qb + (wave >> 1);
    const int skey = tid >> 3, schunk = tid & 7;
    const bf16* gK = QKVS + (rowbase + skey) * 1536 + 512 + h * 64 + schunk * 8;
    const bf16* gV = gK + 512;
    const int kst = skey * KPITCH + schunk * 16, vst = KBUF + (schunk >> 2) * 4096 + skey * 64 + (schunk & 3) * 16;
    volatile LAS unsigned* flags = (volatile LAS unsigned*)(lds + FLAG_OFF);
    __syncthreads();
    v4u kreg = *(const GAS v4u*)(gK + (size_t)Ttop * 64 * 1536), vreg = *(const GAS v4u*)(gV + (size_t)Ttop * 64 * 1536);
    *(LAS v4u*)(lds + kst) = kreg; *(LAS v4u*)(lds + vst) = vreg;
    __syncthreads();
    int cur = 0;
    const int vlane = (4 * hi + ((lane & 15) >> 2)) * 64 + (((lane >> 4) & 1) * 16 + (lane & 3) * 4) * 2;
    for (int T = Ttop; T >= 0; --T) {
        if (T > 0) { kreg = *(const GAS v4u*)(gK + (size_t)(T - 1) * 64 * 1536); vreg = *(const GAS v4u*)(gV + (size_t)(T - 1) * 64 * 1536); }
        if (T <= wstart) {
            const LAS unsigned char* kb = lds + cur * BUFSZ; const LAS unsigned char* vb = kb + KBUF;
            f32x16 p0, p1;
#pragma unroll
            for (int i = 0; i < 16; ++i) { p0[i] = 0.f; p1[i] = 0.f; }
#pragma unroll
            for (int ks = 0; ks < 4; ++ks) {
                const bf16x8 a0 = *(const LAS bf16x8*)(kb + r32 * KPITCH + (2 * ks + hi) * 16);
                const bf16x8 a1 = *(const LAS bf16x8*)(kb + (32 + r32) * KPITCH + (2 * ks + hi) * 16);
                p0 = __builtin_amdgcn_mfma_f32_32x32x16_bf16(a0, qf[ks], p0, 0, 0, 0);
                p1 = __builtin_amdgcn_mfma_f32_32x32x16_bf16(a1, qf[ks], p1, 0, 0, 0);
            }
            const bool diag = (T == wstart);
            const int qrel = 32 * (wave & 1) + r32;
            float sp[2][16], xx[2][16];
#pragma unroll
            for (int blk = 0; blk < 2; ++blk)
#pragma unroll
                for (int r = 0; r < 16; ++r) {
                    const float z = blk ? p1[r] : p0[r];
                    const float e1 = __builtin_amdgcn_exp2f(-fabsf(z));
                    float s = fmaxf(z, 0.f) + __builtin_amdgcn_logf(1.0f + e1);
                    if (diag && (32 * blk + crow(r, hi) >= qrel)) s = 0.f;
                    sp[blk][r] = s; xx[blk][r] = z - s;
                }
            float Tq[2][4], lo[2][4];
#pragma unroll
            for (int blk = 0; blk < 2; ++blk)
#pragma unroll
                for (int g = 0; g < 4; ++g) {
                    const float qs = (sp[blk][4 * g] + sp[blk][4 * g + 1]) + (sp[blk][4 * g + 2] + sp[blk][4 * g + 3]);
                    auto rr = __builtin_amdgcn_permlane32_swap(__float_as_uint(qs), __float_as_uint(qs), false, false);
                    const float f0 = __uint_as_float(rr[0]), f1 = __uint_as_float(rr[1]);
                    Tq[blk][g] = f0 + f1; lo[blk][g] = hi ? 0.f : f1;
                }
            float run = carry; float w[2][16];
#pragma unroll
            for (int blk = 1; blk >= 0; --blk)
#pragma unroll
                for (int g = 3; g >= 0; --g) {
                    const float a3 = run + lo[blk][g]; const float a2 = a3 + sp[blk][4 * g + 3]; const float a1 = a2 + sp[blk][4 * g + 2]; const float a0 = a1 + sp[blk][4 * g + 1];
                    w[blk][4 * g + 3] = __builtin_amdgcn_exp2f(xx[blk][4 * g + 3] - a3); w[blk][4 * g + 2] = __builtin_amdgcn_exp2f(xx[blk][4 * g + 2] - a2);
                    w[blk][4 * g + 1] = __builtin_amdgcn_exp2f(xx[blk][4 * g + 1] - a1); w[blk][4 * g + 0] = __builtin_amdgcn_exp2f(xx[blk][4 * g + 0] - a0);
                    run += Tq[blk][g];
                }
            carry = run;
            if (diag) {
#pragma unroll
                for (int blk = 0; blk < 2; ++blk)
#pragma unroll
                    for (int r = 0; r < 16; ++r) if (32 * blk + crow(r, hi) >= qrel) w[blk][r] = 0.f;
            }
            bf16x8 pf[4];
#pragma unroll
            for (int s4 = 0; s4 < 4; ++s4) { const int blk = s4 >> 1, s = s4 & 1; v4u t;
                t.x = cvtpk(w[blk][8 * s + 0], w[blk][8 * s + 1]); t.y = cvtpk(w[blk][8 * s + 2], w[blk][8 * s + 3]); t.z = cvtpk(w[blk][8 * s + 4], w[blk][8 * s + 5]); t.w = cvtpk(w[blk][8 * s + 6], w[blk][8 * s + 7]);
                pf[s4] = __builtin_bit_cast(bf16x8, t); }
#pragma unroll
            for (int s4 = 0; s4 < 4; ++s4) {
#pragma unroll
                for (int d0 = 0; d0 < 2; ++d0) {
                    const LAS unsigned char* vp = vb + d0 * 4096 + s4 * 16 * 64 + vlane;
                    const s16x4 l4 = vtr(vp), h4 = vtr(vp + 8 * 64);
                    const bf16x8 bv = (bf16x8){l4[0], l4[1], l4[2], l4[3], h4[0], h4[1], h4[2], h4[3]};
                    if (d0 == 0) o0 = __builtin_amdgcn_mfma_f32_32x32x16_bf16(pf[s4], bv, o0, 0, 0, 0);
                    else o1 = __builtin_amdgcn_mfma_f32_32x32x16_bf16(pf[s4], bv, o1, 0, 0, 0);
                }
            }
        }
        const int wdone = __all(carry >= A_DONE) ? 1 : 0;
        if (lane == 0) flags[(T & 1) * 8 + wave] = (unsigned)wdone;
        if (T > 0) { *(LAS v4u*)(lds + (cur ^ 1) * BUFSZ + kst) = kreg; *(LAS v4u*)(lds + (cur ^ 1) * BUFSZ + vst) = vreg; }
        __syncthreads();
        unsigned alld = 1u;
#pragma unroll
        for (int i = 0; i < 8; ++i) alld &= flags[(T & 1) * 8 + i];
        if (alld) break;
        cur ^= 1;
    }
#pragma unroll
    for (int r = 0; r < 16; ++r) {
        bf16* op = O2 + (rowbase + q0w + crow(r, hi)) * 1024 + h * 64 + r32;
        op[0] = (bf16)f2bf(o0[r]); op[32] = (bf16)f2bf(o1[r]);
    }
}
}

namespace retn {
constexpr int RP = 272;
constexpr int QB_OFF = 0, KB_OFF = 64 * RP, VB_OFF = 2 * 64 * RP, SC_OFF = 3 * 64 * RP, SCP = 144, OB_OFF = SC_OFF + 64 * SCP, OBP = 144, RET_LDS_END = OB_OFF + 64 * OBP * 4;
static_assert(RET_LDS_END <= RING_BYTES, "retention LDS");
typedef short s16x4 __attribute__((ext_vector_type(4)));
typedef short v4i16_t __attribute__((ext_vector_type(4)));
typedef unsigned v2u __attribute__((ext_vector_type(2)));
__device__ __forceinline__ s16x4 vtr(const LAS unsigned char* p) { return __builtin_bit_cast(s16x4, __builtin_amdgcn_ds_read_tr16_b64_v4i16((LAS v4i16_t*)p)); }
__device__ __forceinline__ unsigned cvtpk(float lo, float hi) { unsigned r; asm volatile("v_cvt_pk_bf16_f32 %0, %1, %2" : "=v"(r) : "v"(lo), "v"(hi)); return r; }
__device__ __forceinline__ bf16x8 cat8(s16x4 a, s16x4 b) { return (bf16x8){a[0], a[1], a[2], a[3], b[0], b[1], b[2], b[3]}; }

__device__ __forceinline__ void ret_unit(LAS unsigned char* lds, const bf16* RET, bf16* O2, int b, int h, int tid, int lane, int wave) {
    const int l15 = lane & 15, g = lane >> 4;
    const float gamma = 1.0f - __builtin_amdgcn_exp2f(-5.0f - (float)h);
    const float lg = __builtin_amdgcn_logf(gamma);
    const int srow = tid >> 3, scp = tid & 7;
    const bf16* gsrc = RET + ((size_t)b * SEQ + srow) * 2048 + h * 128 + scp * 16;
    const int sdst = srow * RP + scp * 32;
    v4u qreg[2], kreg[2], vreg[2];
#pragma unroll
    for (int i = 0; i < 2; ++i) { qreg[i] = *(const GAS v4u*)(gsrc + i * 8); kreg[i] = *(const GAS v4u*)(gsrc + 512 + i * 8); vreg[i] = *(const GAS v4u*)(gsrc + 1024 + i * 8); }
    __syncthreads();
#pragma unroll
    for (int i = 0; i < 2; ++i) { *(LAS v4u*)(lds + QB_OFF + sdst + 16 * i) = qreg[i]; *(LAS v4u*)(lds + KB_OFF + sdst + 16 * i) = kreg[i]; *(LAS v4u*)(lds + VB_OFF + sdst + 16 * i) = vreg[i]; }
    __syncthreads();
    f32x4 Sacc[8];
#pragma unroll
    for (int d = 0; d < 8; ++d) Sacc[d] = (f32x4){0.f, 0.f, 0.f, 0.f};
    const int ct = wave >> 1;
    const int trl = (lane & 15) >> 2, trp = lane & 3;
    const float g64 = __builtin_amdgcn_exp2f(64.0f * lg);
    for (int n = 0; n < 32; ++n) {
        if (n < 31) { const bf16* gs = gsrc + (size_t)(n + 1) * 64 * 2048;
#pragma unroll
            for (int i = 0; i < 2; ++i) { qreg[i] = *(const GAS v4u*)(gs + i * 8); kreg[i] = *(const GAS v4u*)(gs + 512 + i * 8); vreg[i] = *(const GAS v4u*)(gs + 1024 + i * 8); } }
#pragma unroll
        for (int t = 0; t < 2; ++t) {
            const int mt = 2 * (wave & 1) + t;
            f32x4 acc = (f32x4){0.f, 0.f, 0.f, 0.f};
            if (mt <= ct) {
#pragma unroll
                for (int ks = 0; ks < 4; ++ks) {
                    const bf16x8 a = *(const LAS bf16x8*)(lds + QB_OFF + (16 * ct + l15) * RP + 64 * ks + 16 * g);
                    const bf16x8 bb = *(const LAS bf16x8*)(lds + KB_OFF + (16 * mt + l15) * RP + 64 * ks + 16 * g);
                    acc = __builtin_amdgcn_mfma_f32_16x16x32_bf16(a, bb, acc, 0, 0, 0);
                }
            }
#pragma unroll
            for (int i = 0; i < 4; ++i) {
                const int c = 16 * ct + 4 * g + i, m = 16 * mt + l15;
                const float v = (c >= m) ? acc[i] * __builtin_amdgcn_exp2f((float)(c - m) * lg) : 0.f;
                *(LAS bf16*)(lds + SC_OFF + c * SCP + m * 2) = (bf16)f2bf(v);
            }
        }
        __syncthreads();
        bf16x8 vf[2];
#pragma unroll
        for (int ks = 0; ks < 2; ++ks) { const LAS unsigned char* p = lds + VB_OFF + (32 * ks + 8 * g + trl) * RP + (16 * wave + 4 * trp) * 2; vf[ks] = cat8(vtr(p), vtr(p + 4 * RP)); }
        f32x4 oacc[4], cacc[4];
#pragma unroll
        for (int cb = 0; cb < 4; ++cb) { oacc[cb] = (f32x4){0.f, 0.f, 0.f, 0.f}; cacc[cb] = (f32x4){0.f, 0.f, 0.f, 0.f}; }
#pragma unroll
        for (int cb = 0; cb < 4; ++cb)
#pragma unroll
            for (int ks = 0; ks < 2; ++ks) if (32 * ks <= 16 * cb + 15) {
                const bf16x8 a = *(const LAS bf16x8*)(lds + SC_OFF + (16 * cb + l15) * SCP + 64 * ks + 16 * g);
                oacc[cb] = __builtin_amdgcn_mfma_f32_16x16x32_bf16(a, vf[ks], oacc[cb], 0, 0, 0);
            }
        bf16x8 bs[4];
#pragma unroll
        for (int ks = 0; ks < 4; ++ks) { v4u t; t.x = cvtpk(Sacc[2 * ks][0], Sacc[2 * ks][1]); t.y = cvtpk(Sacc[2 * ks][2], Sacc[2 * ks][3]); t.z = cvtpk(Sacc[2 * ks + 1][0], Sacc[2 * ks + 1][1]); t.w = cvtpk(Sacc[2 * ks + 1][2], Sacc[2 * ks + 1][3]);
            bs[ks] = __builtin_bit_cast(bf16x8, t); }
#pragma unroll
        for (int cb = 0; cb < 4; ++cb)
#pragma unroll
            for (int ks = 0; ks < 4; ++ks) {
                const LAS unsigned char* p = lds + QB_OFF + (16 * cb + l15) * RP + 64 * ks + 8 * g;
                const v2u lo = *(const LAS v2u*)p, hi2 = *(const LAS v2u*)(p + 32);
                const bf16x8 a = __builtin_bit_cast(bf16x8, (v4u){lo.x, lo.y, hi2.x, hi2.y});
                cacc[cb] = __builtin_amdgcn_mfma_f32_16x16x32_bf16(a, bs[ks], cacc[cb], 0, 0, 0);
            }
#pragma unroll
        for (int cb = 0; cb < 4; ++cb)
#pragma unroll
            for (int i = 0; i < 4; ++i) { const int c = 16 * cb + 4 * g + i;
                const float o = oacc[cb][i] + __builtin_amdgcn_exp2f((float)(c + 1) * lg) * cacc[cb][i];
                *(LAS float*)(lds + OB_OFF + (c * OBP + 16 * wave + l15) * 4) = o; }
        if (n < 31) {
#pragma unroll
            for (int d = 0; d < 8; ++d) Sacc[d] = Sacc[d] * g64;
            bf16x8 vs[2];
#pragma unroll
            for (int ks = 0; ks < 2; ++ks) { const v4u w = __builtin_bit_cast(v4u, vf[ks]); float f[8];
                f[0] = __uint_as_float(w.x << 16); f[1] = __uint_as_float(w.x & 0xffff0000u); f[2] = __uint_as_float(w.y << 16); f[3] = __uint_as_float(w.y & 0xffff0000u);
                f[4] = __uint_as_float(w.z << 16); f[5] = __uint_as_float(w.z & 0xffff0000u); f[6] = __uint_as_float(w.w << 16); f[7] = __uint_as_float(w.w & 0xffff0000u);
#pragma unroll
                for (int j = 0; j < 8; ++j) f[j] *= __builtin_amdgcn_exp2f((float)(63 - 32 * ks - 8 * g - j) * lg);
                v4u t; t.x = cvtpk(f[0], f[1]); t.y = cvtpk(f[2], f[3]); t.z = cvtpk(f[4], f[5]); t.w = cvtpk(f[6], f[7]); vs[ks] = __builtin_bit_cast(bf16x8, t); }
#pragma unroll
            for (int db = 0; db < 8; ++db)
#pragma unroll
                for (int ks = 0; ks < 2; ++ks) { const LAS unsigned char* p = lds + KB_OFF + (32 * ks + 8 * g + trl) * RP + (16 * db + 4 * trp) * 2;
                    const bf16x8 a = cat8(vtr(p), vtr(p + 4 * RP));
                    Sacc[db] = __builtin_amdgcn_mfma_f32_16x16x32_bf16(a, vs[ks], Sacc[db], 0, 0, 0); }
        }
        __syncthreads();
        if (n < 31) {
#pragma unroll
            for (int i = 0; i < 2; ++i) { *(LAS v4u*)(lds + QB_OFF + sdst + 16 * i) = qreg[i]; *(LAS v4u*)(lds + KB_OFF + sdst + 16 * i) = kreg[i]; *(LAS v4u*)(lds + VB_OFF + sdst + 16 * i) = vreg[i]; }
        }
#pragma unroll 2
        for (int rr = 0; rr < 8; ++rr) {
            const int c = 8 * wave + rr; const size_t row = (size_t)b * SEQ + 64 * n + c;
            const float o0 = *(const LAS float*)(lds + OB_OFF + (c * OBP + lane) * 4), o1 = *(const LAS float*)(lds + OB_OFF + (c * OBP + 64 + lane) * 4);
            const bf16* grow = RET + row * 2048 + 1536 + h * 128;
            const float g0 = __uint_as_float((unsigned)grow[lane] << 16), g1 = __uint_as_float((unsigned)grow[64 + lane] << 16);
            const float mean = wave_sum(o0 + o1) * (1.f / 128.f); const float d0 = o0 - mean, d1 = o1 - mean;
            const float var = wave_sum(d0 * d0 + d1 * d1) * (1.f / 128.f); const float rstd = 1.0f / sqrtf(var + GN_EPS);
            bf16* orow = O2 + row * 1024 + 512 + h * 128;
            orow[lane] = (bf16)f2bf(d0 * rstd * g0 * pg8::fast_sigmoid(g0)); orow[64 + lane] = (bf16)f2bf(d1 * rstd * g1 * pg8::fast_sigmoid(g1));
        }
        __syncthreads();
    }
}
}

struct Frame {
    LAS unsigned char* lds;
    volatile LAS unsigned* MISC;
    gu32* ctl;
    int tid, lane, wave;
    int vcu, G;
    const float* x; float* out;
    const float *g_ffn1_pre, *g_ffn1_post, *w1g, *w1u, *w1d, *g_mix_pre, *w_in, *w_psb, *w_pret, *w_out, *g_mix_post, *g_ffn2_pre, *g_ffn2_post, *w2g, *w2u, *w2d;
    unsigned char* ws;
};


__device__ __forceinline__ void tr_block(const float* W, int ldw, int k0, int n0, bf16* WT, int ldt, int drow0, int dk0, LAS float* scr, int lane) {
#pragma unroll 8
    for (int i = 0; i < 32; ++i) { const int kk = 2 * i + (lane >> 5); scr[kk * 33 + (lane & 31)] = W[(size_t)(k0 + kk) * ldw + n0 + (lane & 31)]; }
    LDS_WAIT(); asm volatile("" ::: "memory");
    const int c = lane & 7;
#pragma unroll
    for (int j = 0; j < 4; ++j) { const int n = (lane >> 3) + 8 * j; const LAS float* s = scr + (8 * c) * 33 + n;
        v4u o; o.x = pk2(s[0 * 33], s[1 * 33]); o.y = pk2(s[2 * 33], s[3 * 33]); o.z = pk2(s[4 * 33], s[5 * 33]); o.w = pk2(s[6 * 33], s[7 * 33]);
        *(GAS v4u*)(WT + (size_t)(drow0 + n) * ldt + dk0 + 8 * c) = o; }
    LDS_WAIT(); asm volatile("" ::: "memory");
}
__device__ __forceinline__ void tr_job(int kind, const float* W, int K, int N, bf16* WT, int ldt, int item, LAS float* scr, int lane) {
    const int nblk = N / 32, kb = item / nblk, nb = item % nblk, k0 = 64 * kb, n0 = 32 * nb;
    int drow0 = n0, dk0 = k0;
    if (kind == 1) drow0 = 256 * (n0 >> 7) + (n0 & 127);
    else if (kind == 2) drow0 = 256 * (n0 >> 7) + 128 + (n0 & 127);
    else if (kind == 3) { const int tile = n0 >> 8; if (tile >= 6 && tile < 10) { const int local = n0 & 255, hl = local >> 7, within = local & 127, half = within >> 6, i0 = within & 63; drow0 = 256 * tile + 128 * half + 64 * hl + i0; } }
    else if (kind == 4) drow0 = 256 * (n0 >> 7) + (n0 & 127);
    else if (kind == 5) { drow0 = 256 * (n0 >> 7) + 128 + (n0 & 127); dk0 = 512 + k0; }
    tr_block(W, N, k0, n0, WT, ldt, drow0, dk0, scr, lane);
}

__device__ __forceinline__ void rms_to_bf16(const f32x4 (&v)[4], const float* g, bf16* orow, int lane) {
    float s = 0.f;
#pragma unroll
    for (int j = 0; j < 4; ++j) s += (v[j].x * v[j].x + v[j].y * v[j].y) + (v[j].z * v[j].z + v[j].w * v[j].w);
    const float rs = 1.0f / sqrtf(wave_sum(s) * (1.f / D) + RMS_EPS);
    GAS unsigned long long* o8 = (GAS unsigned long long*)orow + lane;
#pragma unroll
    for (int j = 0; j < 4; ++j) { const f32x4 gg = ((const GAS f32x4*)g)[lane + 64 * j];
        o8[64 * j] = (unsigned long long)pk2(v[j].x * rs * gg.x, v[j].y * rs * gg.y) | ((unsigned long long)pk2(v[j].z * rs * gg.z, v[j].w * rs * gg.w) << 32); }
}
__device__ __forceinline__ void rows_phase(Frame& F, const float* Y, const float* xres, float* xo, const float* g_post, float coef, const float* g_pre, bf16* hn) {
    const int gw = F.vcu * NWAVES + F.wave, NGW = F.G * NWAVES;
    for (int m = gw; m < M; m += NGW) {
        const GAS f32x4* yr = (const GAS f32x4*)(Y + (size_t)m * D) + F.lane;
        const GAS f32x4* xr = (const GAS f32x4*)(xres + (size_t)m * D) + F.lane;
        f32x4 y[4], xv[4]; float s = 0.f;
#pragma unroll
        for (int j = 0; j < 4; ++j) { y[j] = yr[64 * j]; xv[j] = xr[64 * j]; s += (y[j].x * y[j].x + y[j].y * y[j].y) + (y[j].z * y[j].z + y[j].w * y[j].w); }
        const float rs = coef / sqrtf(wave_sum(s) * (1.f / D) + RMS_EPS);
        GAS f32x4* orow = (GAS f32x4*)(xo + (size_t)m * D) + F.lane;
#pragma unroll
        for (int j = 0; j < 4; ++j) { const f32x4 gg = ((const GAS f32x4*)g_post)[F.lane + 64 * j]; xv[j] = xv[j] + y[j] * gg * rs; orow[64 * j] = xv[j]; }
        if (hn) rms_to_bf16(xv, g_pre, hn + (size_t)m * D, F.lane);
    }
}

__device__ __forceinline__ void convert_ffn_weights(Frame& F, const float* wg, const float* wu, const float* wd, LAS float* scr) {
    const int gw = F.vcu * NWAVES + F.wave, NGW = F.G * NWAVES;
    bf16* WGU = (bf16*)(F.ws + WS_WGU); bf16* WD = (bf16*)(F.ws + WS_WD);
    constexpr int I_G = (D / 64) * (FF / 32), I_D = (FF / 64) * (D / 32);
    for (int it = gw; it < 2 * I_G + I_D; it += NGW) {
        int r = it;
        if (r < I_G) { tr_job(1, wg, D, FF, WGU, D, r, scr, F.lane); continue; } r -= I_G;
        if (r < I_G) { tr_job(2, wu, D, FF, WGU, D, r, scr, F.lane); continue; } r -= I_G;
        tr_job(0, wd, FF, D, WD, FF, r, scr, F.lane);
    }
}

__device__ __forceinline__ void p0_prologue(Frame& F) {
    LAS float* scr = (LAS float*)(F.lds + RING_OFF + F.wave * 16384);
    const int gw = F.vcu * NWAVES + F.wave, NGW = F.G * NWAVES;
    convert_ffn_weights(F, F.w1g, F.w1u, F.w1d, scr);
    bf16* WIN = (bf16*)(F.ws + WS_WIN); bf16* WP = (bf16*)(F.ws + WS_WP); bf16* WOUT = (bf16*)(F.ws + WS_WOUT);
    constexpr int I_IN = (D / 64) * (NPROJ / 32), I_P = (512 / 64) * (D / 32), I_O = (D / 64) * (D / 32);
    for (int it = gw; it < I_IN + 2 * I_P + I_O; it += NGW) {
        int r = it;
        if (r < I_IN) { tr_job(3, F.w_in, D, NPROJ, WIN, D, r, scr, F.lane); continue; } r -= I_IN;
        if (r < I_P) { tr_job(4, F.w_psb, 512, D, WP, D, r, scr, F.lane); continue; } r -= I_P;
        if (r < I_P) { tr_job(5, F.w_pret, 512, D, WP, D, r, scr, F.lane); continue; } r -= I_P;
        tr_job(0, F.w_out, D, D, WOUT, D, r, scr, F.lane);
    }
    for (int r = gw; r < 2048; r += NGW) { const int kz = ((r & 255) < 128) ? 512 : 0; *(GAS v4u*)(WP + (size_t)r * 1024 + kz + 8 * F.lane) = (v4u){0u, 0u, 0u, 0u}; }
    { float* ct = (float*)(F.ws + WS_ROPE); float* st = ct + 2048 * 64;
      for (int idx = (F.vcu * NWAVES + F.wave) * 64 + F.lane; idx < 2048 * 64; idx += F.G * NWAVES * 64) {
          const int pos = idx >> 6, i = idx & 63;
          const float inv_freq = exp2f(-(float)i * (13.287712379549449f / 64.0f));
          const float ang = (float)pos * inv_freq;
          const double a = (double)ang; const double k = __builtin_rint(a * 0.15915494309189535);
          const double r = __builtin_fma(-k, 6.283185307179586, a) - k * 2.4492935982947064e-16;
          const float rf = (float)r; ct[idx] = cosf(rf); st[idx] = sinf(rf); } }
    bf16* H = (bf16*)(F.ws + WS_H);
    for (int m = gw; m < M; m += NGW) { const GAS f32x4* xr = (const GAS f32x4*)(F.x + (size_t)m * D) + F.lane; f32x4 v[4];
#pragma unroll
        for (int j = 0; j < 4; ++j) v[j] = xr[64 * j];
        rms_to_bf16(v, F.g_ffn1_pre, H + (size_t)m * D, F.lane); }
}

__device__ __forceinline__ void unpack8(const v4u w, float* f) {
    f[0] = __uint_as_float(w.x << 16); f[1] = __uint_as_float(w.x & 0xffff0000u); f[2] = __uint_as_float(w.y << 16); f[3] = __uint_as_float(w.y & 0xffff0000u);
    f[4] = __uint_as_float(w.z << 16); f[5] = __uint_as_float(w.z & 0xffff0000u); f[6] = __uint_as_float(w.w << 16); f[7] = __uint_as_float(w.w & 0xffff0000u);
}
__device__ __forceinline__ float bf2f(bf16 v) { return __uint_as_float((unsigned)v << 16); }

__device__ __forceinline__ void attn_naive(Frame& F) {
    const bf16* QKVS = (const bf16*)(F.ws + WS_QKVS); bf16* O2 = (bf16*)(F.ws + WS_H);
    const int bx = blockIdx.x;
    for (int bh = bx >> 2; bh < 64; bh += (F.G >> 2)) {
        const int q4 = bx & 3, wv = F.wave;
        const int tb = wv < 4 ? q4 * 4 + wv : 31 - (q4 * 4 + (wv - 4));
        const int t = tb * 64 + F.lane, b = bh >> 3, h = bh & 7;
        const bf16* base = QKVS + (size_t)(b * SEQ) * 1536 + h * 64;
        float q[64], acc[64];
        { const GAS v4u* qp = (const GAS v4u*)(base + (size_t)t * 1536);
#pragma unroll
          for (int j = 0; j < 8; ++j) unpack8(qp[j], q + 8 * j); }
#pragma unroll
        for (int j = 0; j < 64; ++j) acc[j] = 0.f;
        float between = 0.f;
        for (int s = t - 1; s >= 0; --s) {
            const GAS v4u* kp = (const GAS v4u*)(base + (size_t)s * 1536 + 512);
            const GAS v4u* vp = (const GAS v4u*)(base + (size_t)s * 1536 + 1024);
            float z = 0.f;
#pragma unroll
            for (int j = 0; j < 8; ++j) { float kf[8]; unpack8(kp[j], kf);
#pragma unroll
                for (int e = 0; e < 8; ++e) z += q[8 * j + e] * kf[e]; }
            const float lk = -(fmaxf(z, 0.f) + __logf(1.0f + __expf(-fabsf(z))));
            const float w = __expf(z + lk + between);
#pragma unroll
            for (int j = 0; j < 8; ++j) { float vf[8]; unpack8(vp[j], vf);
#pragma unroll
                for (int e = 0; e < 8; ++e) acc[8 * j + e] += w * vf[e]; }
            between += lk;
        }
        GAS v4u* op = (GAS v4u*)(O2 + (size_t)(b * SEQ + t) * 1024 + h * 64);
#pragma unroll
        for (int j = 0; j < 8; ++j) { v4u w; w.x = pk2(acc[8 * j], acc[8 * j + 1]); w.y = pk2(acc[8 * j + 2], acc[8 * j + 3]); w.z = pk2(acc[8 * j + 4], acc[8 * j + 5]); w.w = pk2(acc[8 * j + 6], acc[8 * j + 7]); op[j] = w; }
    }
}

__device__ __forceinline__ void ret_naive(Frame& F) {
    const bf16* RET = (const bf16*)(F.ws + WS_RET); bf16* O2 = (bf16*)(F.ws + WS_H);
    LAS float* red = (LAS float*)(F.lds + RING_OFF);
    for (int bh = blockIdx.x; bh < 32; bh += F.G) {
        const int b = bh >> 2, h = bh & 3;
        const float gamma = 1.0f - exp2f(-5.0f - (float)h);
        const int e = F.tid & 127, dg = F.tid >> 7;
        float S[32];
#pragma unroll
        for (int i = 0; i < 32; ++i) S[i] = 0.f;
        for (int t0 = 0; t0 < SEQ; t0 += 8) {
#pragma unroll 1
            for (int j = 0; j < 8; ++j) {
                const bf16* row = RET + (size_t)(b * SEQ + t0 + j) * 2048;
                const float vv = bf2f(row[1024 + h * 128 + e]);
                const GAS v4u* qp = (const GAS v4u*)(row + h * 128 + 32 * dg);
                const GAS v4u* kp = (const GAS v4u*)(row + 512 + h * 128 + 32 * dg);
                float p = 0.f;
#pragma unroll
                for (int c = 0; c < 4; ++c) { float qf[8], kf[8]; unpack8(qp[c], qf); unpack8(kp[c], kf);
#pragma unroll
                    for (int i = 0; i < 8; ++i) { S[8 * c + i] = gamma * S[8 * c + i] + kf[i] * vv; p += qf[i] * S[8 * c + i]; } }
                red[(j * 4 + dg) * 128 + e] = p;
            }
            __syncthreads();
            { const int j = F.wave; const bf16* row = RET + (size_t)(b * SEQ + t0 + j) * 2048;
              const float o0 = (red[(j * 4 + 0) * 128 + F.lane] + red[(j * 4 + 1) * 128 + F.lane]) + (red[(j * 4 + 2) * 128 + F.lane] + red[(j * 4 + 3) * 128 + F.lane]);
              const float o1 = (red[(j * 4 + 0) * 128 + 64 + F.lane] + red[(j * 4 + 1) * 128 + 64 + F.lane]) + (red[(j * 4 + 2) * 128 + 64 + F.lane] + red[(j * 4 + 3) * 128 + 64 + F.lane]);
              const float mean = wave_sum(o0 + o1) * (1.f / 128.f); const float d0 = o0 - mean, d1 = o1 - mean;
              const float var = wave_sum(d0 * d0 + d1 * d1) * (1.f / 128.f); const float rstd = 1.0f / sqrtf(var + GN_EPS);
              const float g0 = bf2f(row[1536 + h * 128 + F.lane]), g1 = bf2f(row[1536 + h * 128 + 64 + F.lane]);
              bf16* orow = O2 + (size_t)(b * SEQ + t0 + j) * 1024 + 512 + h * 128;
              orow[F.lane] = (bf16)f2bf(d0 * rstd * g0 * pg8::fast_sigmoid(g0)); orow[64 + F.lane] = (bf16)f2bf(d1 * rstd * g1 * pg8::fast_sigmoid(g1)); }
            __syncthreads();
        }
    }
}

struct Args { const float* in[17]; float* out; unsigned char* ws; int ph_lo, ph_hi, li, pad; };
__global__ void __launch_bounds__(NWAVES * 64, 2) skel_fwd(Args args) {
    extern __shared__ __attribute__((aligned(16))) unsigned char lds[];
    Frame F;
    F.lds = (LAS unsigned char*)lds;
    F.MISC = (volatile LAS unsigned*)(F.lds + MISC_OFF);
    F.tid = threadIdx.x; F.lane = F.tid & 63; F.wave = __builtin_amdgcn_readfirstlane(F.tid >> 6);
    F.G = gridDim.x; { const int bx = blockIdx.x; F.vcu = (F.G % 8 == 0) ? (bx % 8) * (F.G / 8) + bx / 8 : bx; }
#define GRID_BAR(seam) do { if (N_LAUNCHES == NPHASE) { if (F.tid == 0) __hip_atomic_store(F.ctl + CW_TMO, 0xBADBA0u | (unsigned)(seam), RLX_AGENT); } \
    else { xcd_barrier(bar); } } while (0)
    unsigned char* ws = args.ws; F.ws = ws;
    F.ctl = (gu32*)(ws + WS_CTL);
    F.x = args.in[0]; F.g_ffn1_pre = args.in[1]; F.g_ffn1_post = args.in[2]; F.w1g = args.in[3]; F.w1u = args.in[4]; F.w1d = args.in[5];
    F.g_mix_pre = args.in[6]; F.w_in = args.in[7]; F.w_psb = args.in[8]; F.w_pret = args.in[9]; F.w_out = args.in[10]; F.g_mix_post = args.in[11];
    F.g_ffn2_pre = args.in[12]; F.g_ffn2_post = args.in[13]; F.w2g = args.in[14]; F.w2u = args.in[15]; F.w2d = args.in[16]; F.out = args.out;
    for (int u = F.tid; u < (LDS_BYTES - LDSCTL_OFF) / 4; u += NWAVES * 64) ((LAS unsigned*)(F.lds + LDSCTL_OFF))[u] = 0u;
    __syncthreads();
    XcdBarrier bar; bar.bar = (unsigned*)(F.ctl + CW_BAR); bar.x = 0; bar.st = nullptr;
    if (N_LAUNCHES != NPHASE) bar = xcd_barrier_post((unsigned*)(F.ctl + CW_BAR), F.MISC + 8);

    const int lo = args.ph_lo, hi = args.ph_hi;
#define IN(k) (lo <= (k) && (k) < hi)
#define BOTH(k) (IN(k) && IN((k) + 1))
    bf16* H = (bf16*)(ws + WS_H);
    bf16* ACT = (bf16*)(ws + WS_ACT);

    if (IN(0)) { p0_prologue(F); if (BOTH(0)) GRID_BAR(0); }
    if (IN(1)) { pg8::Gemm g{H, (const bf16*)(ws + WS_WGU), M, 2 * FF, D}; pg8::StaticOrder S; S.init(M, 2 * FF, F.G, (int)blockIdx.x);
        pg8::EpiSwiGLU E{ACT, FF};
        pg8::gemm_phase<pg8::EpiSwiGLU, pg8::StaticOrder, true, true>(F.lds + RING_OFF, g, S, E);
        if (BOTH(1)) GRID_BAR(1); }
    if (IN(2)) { pg8::Gemm g{ACT, (const bf16*)(ws + WS_WD), M, D, FF}; pg8::StaticOrder S; S.init(M, D, F.G, (int)blockIdx.x);
        pg8::EpiF32 E{F.out, D};
        pg8::gemm_phase<pg8::EpiF32, pg8::StaticOrder, true, true>(F.lds + RING_OFF, g, S, E);
        if (BOTH(2)) GRID_BAR(2); }
    if (IN(3)) { rows_phase(F, F.out, F.x, F.out, F.g_ffn1_post, 0.5f, F.g_mix_pre, H);
        convert_ffn_weights(F, F.w2g, F.w2u, F.w2d, (LAS float*)(F.lds + RING_OFF + F.wave * 16384));
        if (BOTH(3)) GRID_BAR(3); }
    if (IN(4)) { pg8::Gemm g{H, (const bf16*)(ws + WS_WIN), M, NPROJ, D}; pg8::StaticOrder S; S.init(M, NPROJ, F.G, (int)blockIdx.x);
        pg8::EpiProj E{(bf16*)(ws + WS_QKVS), (bf16*)(ws + WS_RET), (bf16*)(ws + WS_GATES), (const float*)(ws + WS_ROPE), (const float*)(ws + WS_ROPE) + 2048 * 64};
        pg8::gemm_phase<pg8::EpiProj, pg8::StaticOrder, true, true>(F.lds + RING_OFF, g, S, E);
        if (BOTH(4)) GRID_BAR(4); }
    if (IN(5)) {
        const int R = (F.G >= 64) ? 32 : 0, bx = (int)blockIdx.x;
        if (R == 0 || bx < R) { for (int u = bx; u < 32; u += (R ? R : F.G)) retn::ret_unit(F.lds + RING_OFF, (const bf16*)(ws + WS_RET), H, u >> 2, u & 3, F.tid, F.lane, F.wave); }
        if (R == 0 || bx >= R) { const int na = F.G - R, a0 = bx - R;
            for (int u = a0; u < 512; u += na) sba::attn_unit(F.lds + RING_OFF, (const bf16*)(ws + WS_QKVS), H, u >> 6, (u >> 3) & 7, u & 7, F.tid, F.lane, F.wave); }
        if (BOTH(5)) GRID_BAR(5); }
    if (IN(6)) { pg8::Gemm g{H, (const bf16*)(ws + WS_WP), M, 2 * D, D}; pg8::StaticOrder S; S.init(M, 2 * D, F.G, (int)blockIdx.x);
        pg8::EpiMerge E{(bf16*)(ws + WS_MERGED), (const bf16*)(ws + WS_GATES)};
        pg8::gemm_phase<pg8::EpiMerge, pg8::StaticOrder, true, true>(F.lds + RING_OFF, g, S, E);
        if (BOTH(6)) GRID_BAR(6); }
    if (IN(7)) { pg8::Gemm g{(const bf16*)(ws + WS_MERGED), (const bf16*)(ws + WS_WOUT), M, D, D}; pg8::StaticOrder S; S.init(M, D, F.G, (int)blockIdx.x);
        pg8::EpiF32 E{(float*)(ws + WS_Z), D};
        pg8::gemm_phase<pg8::EpiF32, pg8::StaticOrder, true, true>(F.lds + RING_OFF, g, S, E);
        if (BOTH(7)) GRID_BAR(7); }
    if (IN(8)) { rows_phase(F, (const float*)(ws + WS_Z), F.out, F.out, F.g_mix_post, 1.0f, F.g_ffn2_pre, H); if (BOTH(8)) GRID_BAR(8); }
    if (IN(9)) { pg8::Gemm g{H, (const bf16*)(ws + WS_WGU), M, 2 * FF, D}; pg8::StaticOrder S; S.init(M, 2 * FF, F.G, (int)blockIdx.x);
        pg8::EpiSwiGLU E{ACT, FF};
        pg8::gemm_phase<pg8::EpiSwiGLU, pg8::StaticOrder, true, true>(F.lds + RING_OFF, g, S, E);
        if (BOTH(9)) GRID_BAR(9); }
    if (IN(10)) { pg8::Gemm g{ACT, (const bf16*)(ws + WS_WD), M, D, FF}; pg8::StaticOrder S; S.init(M, D, F.G, (int)blockIdx.x);
        pg8::EpiF32 E{(float*)(ws + WS_Y2), D};
        pg8::gemm_phase<pg8::EpiF32, pg8::StaticOrder, true, true>(F.lds + RING_OFF, g, S, E);
        if (BOTH(10)) GRID_BAR(10); }
    if (IN(11)) { rows_phase(F, (const float*)(ws + WS_Y2), F.out, F.out, F.g_ffn2_post, 0.5f, nullptr, nullptr); }
#undef IN
#undef BOTH
}

extern "C" void kernel_launch(void* const* d_in, const int* in_sizes, int n_in, void* d_out, int out_size, void* d_ws, size_t ws_size, hipStream_t stream) {
    static int grid = 0;
    if (grid == 0) {
        if (n_in != 17 || in_sizes[0] != M * D || out_size != M * D || ws_size < WS_END) { fprintf(stderr, "kernel_launch: unexpected shapes: n_in %d in0 %d out %d ws %zu (need %zu)\n", n_in, n_in > 0 ? in_sizes[0] : -1, out_size, ws_size, (size_t)WS_END); grid = -1; return; }
        int dev = 0, cus = 0, per_cu = 0;
        if (hipGetDevice(&dev) != hipSuccess || hipDeviceGetAttribute(&cus, hipDeviceAttributeMultiprocessorCount, dev) != hipSuccess) { fprintf(stderr, "kernel_launch: device query failed\n"); grid = -1; return; }
        if (hipFuncSetAttribute((const void*)skel_fwd, hipFuncAttributeMaxDynamicSharedMemorySize, LDS_BYTES) != hipSuccess) { fprintf(stderr, "kernel_launch: hipFuncSetAttribute failed\n"); grid = -1; return; }
        if (hipOccupancyMaxActiveBlocksPerMultiprocessor(&per_cu, (const void*)skel_fwd, NWAVES * 64, LDS_BYTES) != hipSuccess || per_cu < 1)
            fprintf(stderr, "kernel_launch: note: occupancy query reports %d workgroups per CU\n", per_cu);
        (void)hipGetLastError();
        grid = cus;
        if (grid > 256) grid = 256;
    }
    if (grid < 0) return;
    if (hipMemsetAsync((char*)d_ws + WS_CTL, 0, CTL_ZERO_BYTES, stream) != hipSuccess) { fprintf(stderr, "kernel_launch: memset failed\n"); return; }
    Args a{};
    for (int i = 0; i < 17; ++i) a.in[i] = (const float*)d_in[i];
    a.out = (float*)d_out; a.ws = (unsigned char*)d_ws;
    for (int li = 0; li < N_LAUNCHES; ++li) {
        a.ph_lo = (N_LAUNCHES == NPHASE) ? li : 0; a.ph_hi = (N_LAUNCHES == NPHASE) ? li + 1 : NPHASE; a.li = li;
        hipLaunchKernelGGL(skel_fwd, dim3(grid), dim3(NWAVES * 64), LDS_BYTES, stream, a);
        const hipError_t le = hipPeekAtLastError();
        if (le != hipSuccess) { fprintf(stderr, "kernel_launch: launch %d failed: %s\n", li, hipGetErrorName(le)); break; }
    }
}
```

```cpp
#include <hip/hip_runtime.h>
#include <cstdio>
#include <cstdint>
#include <cmath>
namespace pg8 {
#define PG8_LAS __attribute__((address_space(3)))
typedef unsigned short bf16_t;
typedef short bf16x8 __attribute__((ext_vector_type(8)));
typedef float f32x4 __attribute__((ext_vector_type(4)));
typedef unsigned u32x4 __attribute__((ext_vector_type(4)));
constexpr int BM = 256, BK = 64, HALF = 128, HTB = HALF * BK * 2  , STAGE_BYTES = 8 * HTB, NXCD = 8, WGM = 8;

__host__ __device__ __forceinline__ int lds_byte(int r, int c) { const int st = (r >> 4) * 2 + (c >> 5), rr = r & 15, cc = c & 31, ob = rr * 64 + cc * 2; return st * 1024 + (ob ^ (((ob >> 9) & 1) << 5)); }
__host__ __device__ __forceinline__ void stage_rc(int b, int& R, int& C) { const int st = b / 1024, sb = b % 1024, swz = sb ^ (((sb >> 9) & 1) << 5); R = (st >> 1) * 16 + swz / 64; C = (st & 1) * 32 + (swz % 64) / 2; }
__host__ __device__ __forceinline__ int perm32(int rho) { const int n = rho >> 4, i = rho & 15; return 8 * (i >> 2) + 4 * n + (i & 3); }

struct Unit { int pm, pn; };
struct Gemm { const bf16_t* A; const bf16_t* Bt; int M, N, K; };

struct StaticOrder {
    int nM, nN, nwg, G, c;
    __host__ __device__ void init(int M, int N, int G_, int c_) { nM = M / BM; nN = N / BM; nwg = nM * nN; G = G_; c = c_; }
    __host__ __device__ bool next(int i, Unit& u) const {
        const long L = (long)i * G + c; if (L >= nwg) return false;
        int wgid = (int)L; { const int q = nwg / NXCD, r = nwg % NXCD, xcd = wgid % NXCD, off = wgid / NXCD; wgid = (xcd < r ? xcd * (q + 1) : r * (q + 1) + (xcd - r) * q) + off; }
        const int nig = WGM * nN, gid = wgid / nig, fm = gid * WGM, gsz = (nM - fm) < WGM ? (nM - fm) : WGM;
        u.pm = fm + ((wgid % nig) % gsz); u.pn = (wgid % nig) / gsz; return true;
    }
    __device__ __forceinline__ void a_ready(const Unit&) const {}
    __device__ __forceinline__ void done(const Unit&) const {}
};

__device__ __forceinline__ unsigned cvt_pk_bf16(float lo, float hi) { unsigned r; asm volatile("v_cvt_pk_bf16_f32 %0, %1, %2" : "=v"(r) : "v"(lo), "v"(hi)); return r; }
typedef float f32x2 __attribute__((ext_vector_type(2)));

__device__ __forceinline__ float fast_sigmoid(float x) { return __builtin_amdgcn_rcpf(1.0f + __expf(-x)); }
__device__ __forceinline__ float bf_lo(unsigned w) { return __uint_as_float(w << 16); }
__device__ __forceinline__ float bf_hi(unsigned w) { return __uint_as_float(w & 0xffff0000u); }

struct EpiSwiGLU {
    static constexpr bool PERM = true, AFTER_DRAIN = false;
    bf16_t* O; int ldc;
    __device__ __forceinline__ void operator()(const f32x4 (&acc)[2][2][4][2], const Unit& u, int wr, int wc, int fr, int fq) const {
        const int row0 = u.pm * BM + wr * 64 + fr, col0 = u.pn * HALF + wc * 32 + 8 * fq;
#pragma unroll
        for (int ai = 0; ai < 2; ++ai)
#pragma unroll
            for (int m = 0; m < 4; ++m) {
                bf16_t* rowp = O + (size_t)(row0 + ai * HALF + m * 16) * ldc + col0;
                float v[8];
#pragma unroll
                for (int n = 0; n < 2; ++n)
#pragma unroll
                    for (int e = 0; e < 4; ++e) { const float g = acc[ai][0][m][n][e], up = acc[ai][1][m][n][e]; v[4 * n + e] = g * fast_sigmoid(g) * up; }
                u32x4 w; w.x = cvt_pk_bf16(v[0], v[1]); w.y = cvt_pk_bf16(v[2], v[3]); w.z = cvt_pk_bf16(v[4], v[5]); w.w = cvt_pk_bf16(v[6], v[7]);
                *(u32x4*)rowp = w;
            }
    }
};

struct EpiF32 {
    static constexpr bool PERM = false, AFTER_DRAIN = false;
    float* O; int ldc;
    __device__ __forceinline__ void operator()(const f32x4 (&acc)[2][2][4][2], const Unit& u, int wr, int wc, int fr, int fq) const {
        const int row0 = u.pm * BM + wr * 64 + fr, col0 = u.pn * BM + wc * 32 + 4 * fq;
#pragma unroll
        for (int ai = 0; ai < 2; ++ai)
#pragma unroll
            for (int m = 0; m < 4; ++m) {
                float* rowp = O + (size_t)(row0 + ai * HALF + m * 16) * ldc + col0;
#pragma unroll
                for (int bj = 0; bj < 2; ++bj)
#pragma unroll
                    for (int n = 0; n < 2; ++n) *(f32x4*)(rowp + bj * HALF + n * 16) = acc[ai][bj][m][n];
            }
    }
};

struct EpiProj {
    static constexpr bool PERM = true, AFTER_DRAIN = false;
    bf16_t* QKVS; bf16_t* RET; bf16_t* GATES; const float* ropec; const float* ropes;
    __device__ __forceinline__ void operator()(const f32x4 (&acc)[2][2][4][2], const Unit& u, int wr, int wc, int fr, int fq) const {
        const int row0 = u.pm * BM + wr * 64 + fr; const int pn = u.pn;
        if (pn >= 6 && pn < 10) {
            const float sc = (pn >= 8) ? 0.08838834764831845f : 1.0f;
            const int hd = 2 * ((pn - 6) & 1) + (wc >> 1);
            const float lgam = __builtin_amdgcn_logf(1.0f - __builtin_amdgcn_exp2f(-5.0f - (float)hd)) * ((pn >= 8) ? -1.0f : 1.0f);
            const int hl = wc >> 1, i0 = 32 * (wc & 1) + 8 * fq;
            const int colb = (pn - 6) * BM + hl * 128 + i0;
#pragma unroll
            for (int ai = 0; ai < 2; ++ai)
#pragma unroll
                for (int m = 0; m < 4; ++m) {
                    const int row = row0 + ai * HALF + m * 16; const int pos = row & 2047; const float scd = sc * __builtin_amdgcn_exp2f((float)(pos & 63) * lgam);
                    const f32x4 c0 = *(const f32x4*)(ropec + pos * 64 + i0), c1 = *(const f32x4*)(ropec + pos * 64 + i0 + 4);
                    const f32x4 s0 = *(const f32x4*)(ropes + pos * 64 + i0), s1 = *(const f32x4*)(ropes + pos * 64 + i0 + 4);
                    float o1[8], o2[8];
#pragma unroll
                    for (int n = 0; n < 2; ++n)
#pragma unroll
                        for (int e = 0; e < 4; ++e) { const float x1 = acc[ai][0][m][n][e], x2 = acc[ai][1][m][n][e]; const float c = n ? c1[e] : c0[e], s = n ? s1[e] : s0[e];
                            o1[4 * n + e] = (x1 * c - x2 * s) * scd; o2[4 * n + e] = (x1 * s + x2 * c) * scd; }
                    bf16_t* rowp = RET + (size_t)row * 2048 + colb;
                    u32x4 w; w.x = cvt_pk_bf16(o1[0], o1[1]); w.y = cvt_pk_bf16(o1[2], o1[3]); w.z = cvt_pk_bf16(o1[4], o1[5]); w.w = cvt_pk_bf16(o1[6], o1[7]);
                    *(u32x4*)rowp = w;
                    w.x = cvt_pk_bf16(o2[0], o2[1]); w.y = cvt_pk_bf16(o2[2], o2[3]); w.z = cvt_pk_bf16(o2[4], o2[5]); w.w = cvt_pk_bf16(o2[6], o2[7]);
                    *(u32x4*)(rowp + 64) = w;
                }
            return;
        }
        bf16_t* base; int ldc, colt; float sc = 1.0f;
        if (pn < 6) { base = QKVS; ldc = 1536; colt = pn * BM; if (pn < 2) sc = 0.125f * 1.4426950408889634f; }
        else if (pn < 14) { base = RET; ldc = 2048; colt = (pn - 6) * BM; }
        else { base = GATES; ldc = 2048; colt = (pn - 14) * BM; }
        const int col0 = colt + wc * 32 + 8 * fq;
#pragma unroll
        for (int ai = 0; ai < 2; ++ai)
#pragma unroll
            for (int m = 0; m < 4; ++m) { bf16_t* rowp = base + (size_t)(row0 + ai * HALF + m * 16) * ldc + col0;
#pragma unroll
                for (int bj = 0; bj < 2; ++bj) { const f32x4 v0 = acc[ai][bj][m][0] * sc, v1 = acc[ai][bj][m][1] * sc;
                    u32x4 w; w.x = cvt_pk_bf16(v0[0], v0[1]); w.y = cvt_pk_bf16(v0[2], v0[3]); w.z = cvt_pk_bf16(v1[0], v1[1]); w.w = cvt_pk_bf16(v1[2], v1[3]);
                    *(u32x4*)(rowp + bj * HALF) = w; } }
    }
};

struct EpiMerge {
    static constexpr bool PERM = true, AFTER_DRAIN = false;
    bf16_t* O; const bf16_t* GATES;
    __device__ __forceinline__ void operator()(const f32x4 (&acc)[2][2][4][2], const Unit& u, int wr, int wc, int fr, int fq) const {
        const int row0 = u.pm * BM + wr * 64 + fr, col0 = u.pn * HALF + wc * 32 + 8 * fq;
#pragma unroll
        for (int ai = 0; ai < 2; ++ai)
#pragma unroll
            for (int m = 0; m < 4; ++m) {
                const size_t row = (size_t)(row0 + ai * HALF + m * 16);
                const u32x4 ga = *(const u32x4*)(GATES + row * 2048 + col0), gb = *(const u32x4*)(GATES + row * 2048 + 1024 + col0);
                float a[8], b[8];
                a[0] = bf_lo(ga.x); a[1] = bf_hi(ga.x); a[2] = bf_lo(ga.y); a[3] = bf_hi(ga.y); a[4] = bf_lo(ga.z); a[5] = bf_hi(ga.z); a[6] = bf_lo(ga.w); a[7] = bf_hi(ga.w);
                b[0] = bf_lo(gb.x); b[1] = bf_hi(gb.x); b[2] = bf_lo(gb.y); b[3] = bf_hi(gb.y); b[4] = bf_lo(gb.z); b[5] = bf_hi(gb.z); b[6] = bf_lo(gb.w); b[7] = bf_hi(gb.w);
                float v[8];
#pragma unroll
                for (int n = 0; n < 2; ++n)
#pragma unroll
                    for (int e = 0; e < 4; ++e) v[4 * n + e] = fast_sigmoid(a[4 * n + e]) * acc[ai][0][m][n][e] + fast_sigmoid(b[4 * n + e]) * acc[ai][1][m][n][e];
                u32x4 w; w.x = cvt_pk_bf16(v[0], v[1]); w.y = cvt_pk_bf16(v[2], v[3]); w.z = cvt_pk_bf16(v[4], v[5]); w.w = cvt_pk_bf16(v[6], v[7]);
                *(u32x4*)(O + row * 1024 + col0) = w;
            }
    }
};
template <class Epi, class Sched, bool ALIGN_EPI = false, bool SP2 = false>
__device__ __forceinline__ void gemm_phase(PG8_LAS unsigned char* lds, const Gemm g, const Sched& S, const Epi& E) {
    const int tid = threadIdx.x, wid = __builtin_amdgcn_readfirstlane(tid >> 6), lane = tid & 63, wr = wid >> 2, wc = wid & 3, fr = lane & 15, fq = lane >> 4;
    const int K = g.K, nt = K / BK;
    unsigned voffA[2], voffB[2];
#pragma unroll
    for (int i = 0; i < 2; ++i) { int R, C; stage_rc(tid * 16 + i * 8192, R, C); const int Rb = Epi::PERM ? ((R & ~31) + perm32(R & 31)) : R;
        voffA[i] = (unsigned)(R * K + C) * 2u; voffB[i] = (unsigned)(Rb * K + C) * 2u; }
    const size_t kstep = (size_t)(BK * 2);
    const size_t hstep = (size_t)HALF * K * 2;
    const size_t tstep = 2 * hstep;
    const unsigned ldsw = (unsigned)wid * 1024u;
    const int aoff = lds_byte(wr * 64 + fr, fq * 8), boff = lds_byte(wc * 32 + fr, fq * 8);
#define PG8_SA(b, h) (((b) * 2 + (h)) * HTB)
#define PG8_SB(b, h) ((4 + (b) * 2 + (h)) * HTB)
#define PG8_STAGE(bufoff, gbase, voff) do { _Pragma("unroll") for (int _i = 0; _i < 2; ++_i) \
        __builtin_amdgcn_global_load_lds((const unsigned*)((const char*)(gbase) + (voff)[_i]), (PG8_LAS unsigned*)(lds + (bufoff) + ldsw + _i * 8192), 16, 0, 0); } while (0)
#define PG8_LDA(dst, b, h) do { _Pragma("unroll") for (int m = 0; m < 4; ++m) _Pragma("unroll") for (int k = 0; k < 2; ++k) dst[m][k] = *(const PG8_LAS bf16x8*)(lds + PG8_SA(b, h) + aoff + m * 2048 + k * 1024); } while (0)
#define PG8_LDB(dst, b, h) do { _Pragma("unroll") for (int n = 0; n < 2; ++n) _Pragma("unroll") for (int k = 0; k < 2; ++k) dst[n][k] = *(const PG8_LAS bf16x8*)(lds + PG8_SB(b, h) + boff + n * 2048 + k * 1024); } while (0)
#define PG8_MMA(ai, bj, At, Bt) do { __builtin_amdgcn_s_setprio(1); _Pragma("unroll") for (int m = 0; m < 4; ++m) _Pragma("unroll") for (int n = 0; n < 2; ++n) _Pragma("unroll") for (int k = 0; k < 2; ++k) \
        acc[ai][bj][m][n] = __builtin_amdgcn_mfma_f32_16x16x32_bf16(Bt[n][k], At[m][k], acc[ai][bj][m][n], 0, 0, 0); __builtin_amdgcn_s_setprio(0); } while (0)
#define PG8_WAIT_V(n) asm volatile("s_waitcnt vmcnt(" #n ")" ::: "memory")
#define PG8_WAIT_L(n) asm volatile("s_waitcnt lgkmcnt(" #n ")" ::: "memory")
#define PG8_BAR __builtin_amdgcn_s_barrier()
#define PG8_SCHED __builtin_amdgcn_sched_barrier(0)
    Unit cur, nxt; int ui = 0;
    if (!S.next(0, cur)) return;
    f32x4 acc[2][2][4][2];
#pragma unroll
    for (int a = 0; a < 2; ++a)
#pragma unroll
        for (int b = 0; b < 2; ++b)
#pragma unroll
            for (int m = 0; m < 4; ++m)
#pragma unroll
                for (int n = 0; n < 2; ++n) acc[a][b][m][n] = (f32x4){0.f, 0.f, 0.f, 0.f};
    bf16x8 At[4][2], B0[2][2], B1[2][2];
    const char* cA = (const char*)g.A + (size_t)cur.pm * tstep; const char* cB = (const char*)g.Bt + (size_t)cur.pn * tstep;
    S.a_ready(cur);
    if constexpr (SP2) {
        PG8_STAGE(PG8_SB(0, 0), cB, voffB); PG8_STAGE(PG8_SB(0, 1), cB + hstep, voffB); PG8_STAGE(PG8_SA(0, 0), cA, voffA); PG8_STAGE(PG8_SA(0, 1), cA + hstep, voffA);
        if (wr == 1) PG8_BAR;
        PG8_WAIT_V(2); PG8_BAR;
        PG8_STAGE(PG8_SB(1, 0), cB + kstep, voffB); PG8_STAGE(PG8_SA(1, 0), cA + kstep, voffA); PG8_STAGE(PG8_SB(1, 1), cB + hstep + kstep, voffB);
        PG8_WAIT_V(6); PG8_BAR;
    } else {
        PG8_STAGE(PG8_SB(0, 0), cB, voffB); PG8_STAGE(PG8_SA(0, 0), cA, voffA); PG8_STAGE(PG8_SB(0, 1), cB + hstep, voffB); PG8_STAGE(PG8_SA(0, 1), cA + hstep, voffA);
        if (wr == 1) PG8_BAR;
        PG8_WAIT_V(4); PG8_BAR;
        PG8_STAGE(PG8_SB(1, 0), cB + kstep, voffB); PG8_STAGE(PG8_SA(1, 0), cA + kstep, voffA); PG8_STAGE(PG8_SB(1, 1), cB + hstep + kstep, voffB);
        PG8_WAIT_V(6); PG8_BAR;
    }
    for (;;) {
        const bool has_next = S.next(ui + 1, nxt);
        const char* nA = has_next ? (const char*)g.A + (size_t)nxt.pm * tstep : cA; const char* nB = has_next ? (const char*)g.Bt + (size_t)nxt.pn * tstep : cB;
        for (int t = 0; t < nt; t += 2) {
            const bool last = (t == nt - 2);
            const char* a1 = cA + (size_t)(t + 1) * kstep;
            const char* a2 = last ? nA : cA + (size_t)(t + 2) * kstep; const char* b2 = last ? nB : cB + (size_t)(t + 2) * kstep;
            const char* a3 = a2 + kstep; const char* b3 = b2 + kstep;
            if (last && has_next) S.a_ready(nxt);
            if constexpr (SP2) {
            PG8_LDB(B0, 0, 0); PG8_LDB(B1, 0, 1); PG8_SCHED; PG8_LDA(At, 0, 0); PG8_STAGE(PG8_SA(1, 1), a1 + hstep, voffA);
            PG8_WAIT_V(8); PG8_WAIT_L(0); PG8_BAR; PG8_MMA(0, 0, At, B0); PG8_MMA(0, 1, At, B1); PG8_BAR; PG8_SCHED;
            PG8_LDA(At, 0, 1); PG8_STAGE(PG8_SB(0, 0), b2, voffB); PG8_STAGE(PG8_SB(0, 1), b2 + hstep, voffB); PG8_STAGE(PG8_SA(0, 0), a2, voffA);
            PG8_WAIT_V(8); PG8_WAIT_L(0); PG8_BAR; PG8_MMA(1, 0, At, B0); PG8_MMA(1, 1, At, B1); PG8_BAR; PG8_SCHED;
            PG8_LDB(B0, 1, 0); PG8_LDB(B1, 1, 1); PG8_SCHED; PG8_LDA(At, 1, 0); PG8_STAGE(PG8_SA(0, 1), a2 + hstep, voffA);
            PG8_WAIT_V(8); PG8_WAIT_L(0); PG8_BAR; PG8_MMA(0, 0, At, B0); PG8_MMA(0, 1, At, B1); PG8_BAR; PG8_SCHED;
            PG8_LDA(At, 1, 1); PG8_STAGE(PG8_SB(1, 0), b3, voffB); PG8_STAGE(PG8_SB(1, 1), b3 + hstep, voffB); PG8_STAGE(PG8_SA(1, 0), a3, voffA);
            PG8_WAIT_V(8); PG8_WAIT_L(0); PG8_BAR; PG8_MMA(1, 0, At, B0); PG8_MMA(1, 1, At, B1); PG8_BAR; PG8_SCHED;
            } else {
            PG8_LDB(B0, 0, 0); PG8_SCHED; PG8_LDA(At, 0, 0); PG8_STAGE(PG8_SA(1, 1), a1 + hstep, voffA);
            PG8_WAIT_L(8); PG8_BAR; PG8_WAIT_L(0); PG8_MMA(0, 0, At, B0); PG8_BAR; PG8_SCHED;
            PG8_LDB(B1, 0, 1); PG8_STAGE(PG8_SB(0, 0), b2, voffB);
            PG8_BAR; PG8_WAIT_L(0); PG8_MMA(0, 1, At, B1); PG8_BAR;
            PG8_LDA(At, 0, 1); PG8_STAGE(PG8_SA(0, 0), a2, voffA);
            PG8_BAR; PG8_WAIT_L(0); PG8_MMA(1, 0, At, B0); PG8_BAR; PG8_SCHED;
            PG8_STAGE(PG8_SB(0, 1), b2 + hstep, voffB);
            PG8_WAIT_V(6); PG8_BAR; PG8_MMA(1, 1, At, B1); PG8_BAR;
            PG8_LDB(B0, 1, 0); PG8_SCHED; PG8_LDA(At, 1, 0); PG8_STAGE(PG8_SA(0, 1), a2 + hstep, voffA);
            PG8_WAIT_L(8); PG8_BAR; PG8_WAIT_L(0); PG8_MMA(0, 0, At, B0); PG8_BAR; PG8_SCHED;
            PG8_LDB(B1, 1, 1); PG8_STAGE(PG8_SB(1, 0), b3, voffB);
            PG8_BAR; PG8_WAIT_L(0); PG8_MMA(0, 1, At, B1); PG8_BAR;
            PG8_LDA(At, 1, 1); PG8_STAGE(PG8_SA(1, 0), a3, voffA);
            PG8_BAR; PG8_WAIT_L(0); PG8_MMA(1, 0, At, B0); PG8_BAR; PG8_SCHED;
            PG8_STAGE(PG8_SB(1, 1), b3 + hstep, voffB);
            PG8_WAIT_V(6); PG8_BAR; PG8_MMA(1, 1, At, B1); PG8_BAR;
            }
        }
        if constexpr (ALIGN_EPI) { if (wr == 0) PG8_BAR; }
        if constexpr (!Epi::AFTER_DRAIN) { E(acc, cur, wr, wc, fr, fq); S.done(cur); }
        if (!has_next) break;
#pragma unroll
        for (int a = 0; a < 2; ++a)
#pragma unroll
            for (int b = 0; b < 2; ++b)
#pragma unroll
                for (int m = 0; m < 4; ++m)
#pragma unroll
                    for (int n = 0; n < 2; ++n) acc[a][b][m][n] = (f32x4){0.f, 0.f, 0.f, 0.f};
        cur = nxt; cA = nA; cB = nB; ++ui;
        if constexpr (ALIGN_EPI) { if (wr == 1) PG8_BAR; }
    }
    PG8_WAIT_V(0);
    if constexpr (!ALIGN_EPI) { if (wr == 0) PG8_BAR; }
    PG8_BAR;
    if constexpr (Epi::AFTER_DRAIN) { E.fused(acc, cur, wr, wc, fr, fq, lds, wid, lane); S.done(cur); }
#undef PG8_SA
#undef PG8_SB
#undef PG8_STAGE
#undef PG8_LDA
#undef PG8_LDB
#undef PG8_MMA
#undef PG8_WAIT_V
#undef PG8_WAIT_L
#undef PG8_BAR
#undef PG8_SCHED
}
}
#define GAS __attribute__((address_space(1)))
#define LAS __attribute__((address_space(3)))
typedef unsigned short bf16;
typedef unsigned v4u __attribute__((ext_vector_type(4)));
typedef float f32x4 __attribute__((ext_vector_type(4)));
typedef short bf16x8 __attribute__((ext_vector_type(8)));
typedef GAS unsigned gu32;
typedef GAS unsigned long long gu64;
#define RLX_AGENT __ATOMIC_RELAXED, __HIP_MEMORY_SCOPE_AGENT
#define LDS_WAIT() asm volatile("s_waitcnt lgkmcnt(0)" ::: "memory")
#define VM_WAIT() asm volatile("s_waitcnt vmcnt(0)" ::: "memory")
__device__ __forceinline__ unsigned long long rt() { return __builtin_amdgcn_s_memrealtime(); }
__device__ __forceinline__ unsigned f2bf(float f) { unsigned u = __builtin_bit_cast(unsigned, f); return (u + 0x7fffu + ((u >> 16) & 1u)) >> 16; }
__device__ __forceinline__ unsigned pk2(float lo, float hi) { return f2bf(lo) | (f2bf(hi) << 16); }

#define XB_TMO      128
#define XB_XCNT(j)  (256  + 64 * (j))
#define XB_XSUB(j)  (1280 + 64 * (j))
#define XB_XGEN(j)  (2304 + 64 * (j))
#define XB_TOP      3328
#define XB_TOPGEN   3392
#define XCD_BAR_WORDS 3456
#define XB_SPIN_CAP (1u << 18)

__device__ __forceinline__ unsigned xb_ld(unsigned* p)              { return __hip_atomic_load(p, __ATOMIC_RELAXED, __HIP_MEMORY_SCOPE_AGENT); }
__device__ __forceinline__ unsigned xb_add(unsigned* p, unsigned v) { return __hip_atomic_fetch_add(p, v, __ATOMIC_RELAXED, __HIP_MEMORY_SCOPE_AGENT); }
__device__ __forceinline__ unsigned xb_xcc_id() { return (unsigned)__builtin_amdgcn_s_getreg((3 << 11) | 20) & 0xFu; }
#define XB_SPIN(cond, bar) do { unsigned _sp = 0; while (cond) { __builtin_amdgcn_s_sleep(1); \
    if ((++_sp & 255u) == 0u) { if (xb_ld(&(bar)[XB_TMO])) break; if (_sp > XB_SPIN_CAP) { atomicAdd(&(bar)[XB_TMO], 1u); break; } } } } while (0)

struct XcdBarrier {
    unsigned* bar; unsigned x;
    volatile LAS unsigned* st;
};

__device__ __forceinline__ XcdBarrier xcd_barrier_post(unsigned* bar, volatile LAS unsigned* st) {
    XcdBarrier b; b.bar = bar; b.x = xb_xcc_id(); b.st = st;
    if (threadIdx.x == 0) (void)xb_add(&bar[XB_XCNT(b.x)], 1u);
    return b;
}
__device__ __forceinline__ void xcd_barrier_complete(unsigned* bar, unsigned x, unsigned& nloc, unsigned& nx) {
    const unsigned G = gridDim.x * gridDim.y * gridDim.z;
    unsigned sum, cnt, mine, sp = 0u;
    for (;;) {
        sum = 0u; cnt = 0u; mine = 0u;
#pragma unroll
        for (unsigned j = 0; j < 16; ++j) { const unsigned c = xb_ld(&bar[XB_XCNT(j)]); sum += c; cnt += (c > 0u) ? 1u : 0u; mine = (j == x) ? c : mine; }
        if (sum == G) break;
        __builtin_amdgcn_s_sleep(1);
        if ((++sp & 255u) == 0u) { if (xb_ld(&bar[XB_TMO])) break; if (sp > XB_SPIN_CAP) { atomicAdd(&bar[XB_TMO], 1u); break; } }
    }
    nloc = mine > 0u ? mine : 1u; nx = cnt > 0u ? cnt : 1u;
}

__device__ __forceinline__ void xcd_barrier(const XcdBarrier& b) {
    asm volatile("s_waitcnt vmcnt(0)" ::: "memory");
    __syncthreads();
    if (threadIdx.x == 0) {
        unsigned* bar = b.bar;
        __builtin_amdgcn_s_waitcnt(0);
        unsigned nloc = b.st[0], nx = b.st[1];
        if (nloc == 0u) { xcd_barrier_complete(bar, b.x, nloc, nx); b.st[0] = nloc; b.st[1] = nx; }
        const unsigned old = xb_add(&bar[XB_XSUB(b.x)], 1u);
        const unsigned gen = old / nloc;
        if (old + 1u == (gen + 1u) * nloc) {
            __builtin_amdgcn_fence(__ATOMIC_RELEASE, "agent");
            asm volatile("s_waitcnt vmcnt(0)" ::: "memory");
            const unsigned og = xb_add(&bar[XB_TOP], 1u);
            const unsigned tg = og / nx;
            if (og + 1u == (tg + 1u) * nx) xb_add(&bar[XB_TOPGEN], 1u);
            else XB_SPIN(xb_ld(&bar[XB_TOPGEN]) == tg, bar);
            __builtin_amdgcn_fence(__ATOMIC_ACQUIRE, "agent");
            xb_add(&bar[XB_XGEN(b.x)], 1u);
            asm volatile("s_waitcnt vmcnt(0)" ::: "memory");
        } else {
            XB_SPIN(xb_ld(&bar[XB_XGEN(b.x)]) == gen, bar);
            __builtin_amdgcn_fence(__ATOMIC_ACQUIRE, "agent");
            asm volatile("s_waitcnt vmcnt(0)" ::: "memory");
        }
    }
    __syncthreads();
}

constexpr int NWAVES = 8;
#ifndef MK_N_LAUNCHES
#define MK_N_LAUNCHES 1
#endif
constexpr int N_LAUNCHES = MK_N_LAUNCHES;
constexpr int NPHASE = 12;
constexpr int BATCH = 8, SEQ = 2048, D = 1024, FF = 4096, M = BATCH * SEQ;
constexpr int NPROJ = 5632;
constexpr float RMS_EPS = 1e-6f, GN_EPS = 1e-5f;

constexpr size_t MiB = 1u << 20;
constexpr size_t WS_CTL = 0, CTL_ZERO_BYTES = 1 * MiB;
constexpr size_t WS_ROPE = 1 * MiB;
constexpr size_t WS_WD = 2 * MiB;
constexpr size_t WS_H = 10 * MiB;
constexpr size_t WS_WIN = 42 * MiB;
constexpr size_t WS_WP = 53 * MiB;
constexpr size_t WS_WOUT = 57 * MiB;
constexpr size_t WS_WGU = 59 * MiB;
constexpr size_t WS_Y2 = 10 * MiB;
constexpr size_t WS_BIG = 75 * MiB;
constexpr size_t WS_ACT = WS_BIG;
constexpr size_t WS_QKVS = WS_BIG;
constexpr size_t WS_RET = WS_BIG + 48 * MiB;
constexpr size_t WS_GATES = WS_BIG + 112 * MiB;
constexpr size_t WS_MERGED = WS_BIG;
constexpr size_t WS_Z = WS_BIG + 48 * MiB;
constexpr size_t WS_END = 251 * MiB;
static_assert(WS_Y2 + (size_t)M * D * 4 <= WS_BIG && WS_GATES + (size_t)M * 2048 * 2 <= WS_END && WS_WGU + (size_t)8192 * 1024 * 2 <= WS_BIG, "ws map");
constexpr int CW_TMO = 0, CW_CODE = 1;
constexpr int CW_BAR = 4096;

constexpr int RING_OFF = 0, RING_BYTES = 131072;
constexpr int LDSCTL_OFF = RING_BYTES, MISC_OFF = LDSCTL_OFF + 320;
constexpr int LDS_BYTES = 147456;

__device__ __forceinline__ float wave_sum(float v) {
#pragma unroll
    for (int o = 1; o < 64; o <<= 1) v += __shfl_xor(v, o);
    return v;
}

namespace sba {
#define LBAR() do { asm volatile("s_waitcnt lgkmcnt(0)" ::: "memory"); __builtin_amdgcn_s_barrier(); asm volatile("" ::: "memory"); } while (0)
typedef float f32x16 __attribute__((ext_vector_type(16)));
typedef short s16x4 __attribute__((ext_vector_type(4)));
typedef short v4i16_t __attribute__((ext_vector_type(4)));
constexpr int KPITCH = 144, KBUF = 64 * KPITCH, VBUF = 8192, BUFSZ = KBUF + VBUF, FLAG_OFF = 2 * BUFSZ, OST_OFF = FLAG_OFF + 64;
constexpr float A_DONE = 150.0f;
__device__ __forceinline__ int crow(int r, int hi) { return (r & 3) + 8 * (r >> 2) + 4 * hi; }
__device__ __forceinline__ s16x4 vtr(const LAS unsigned char* p) { return __builtin_bit_cast(s16x4, __builtin_amdgcn_ds_read_tr16_b64_v4i16((LAS v4i16_t*)p)); }
__device__ __forceinline__ unsigned cvtpk(float lo, float hi) { unsigned r; asm volatile("v_cvt_pk_bf16_f32 %0, %1, %2" : "=v"(r) : "v"(lo), "v"(hi)); return r; }

__device__ __forceinline__ void attn_unit(LAS unsigned char* lds, const bf16* QKVS, bf16* O2, int b, int h, int qb, int tid, int lane, int wave) {
    const int r32 = lane & 31, hi = lane >> 5;
    const int q0w = 256 * qb + 32 * wave;
    const size_t rowbase = (size_t)b * SEQ;
    bf16x8 qf[4];
#pragma unroll
    for (int ks = 0; ks < 4; ++ks) qf[ks] = *(const GAS bf16x8*)(QKVS + (rowbase + q0w + r32) * 1536 + h * 64 + 16 * ks + 8 * hi);
    f32x16 o0, o1;
#pragma unroll
    for (int i = 0; i < 16; ++i) { o0[i] = 0.f; o1[i] = 0.f; }
    float carry = 0.f;
    const int Ttop = 4 * qb + 3, wstart = 4 * qb + (wave >> 1);
    const int skey = tid >> 3, schunk = tid & 7;
    const bf16* gK = QKVS + (rowbase + skey) * 1536 + 512 + h * 64 + schunk * 8;
    const bf16* gV = gK + 512;
    const int kst = skey * KPITCH + schunk * 16, vst = KBUF + (schunk >> 2) * 4096 + skey * 64 + (schunk & 3) * 16;
    volatile LAS unsigned* flags = (volatile LAS unsigned*)(lds + FLAG_OFF);
    __syncthreads();
    v4u kreg = *(const GAS v4u*)(gK + (size_t)Ttop * 64 * 1536), vreg = *(const GAS v4u*)(gV + (size_t)Ttop * 64 * 1536);
    *(LAS v4u*)(lds + kst) = kreg; *(LAS v4u*)(lds + vst) = vreg;
    __syncthreads();
    int cur = 0;
    const int vlane = (4 * hi + ((lane & 15) >> 2)) * 64 + (((lane >> 4) & 1) * 16 + (lane & 3) * 4) * 2;
    for (int T = Ttop; T >= 0; --T) {
        if (T > 0) { kreg = *(const GAS v4u*)(gK + (size_t)(T - 1) * 64 * 1536); vreg = *(const GAS v4u*)(gV + (size_t)(T - 1) * 64 * 1536); }
        if (T <= wstart) {
            const LAS unsigned char* kb = lds + cur * BUFSZ; const LAS unsigned char* vb = kb + KBUF;
            f32x16 p0, p1;
#pragma unroll
            for (int i = 0; i < 16; ++i) { p0[i] = 0.f; p1[i] = 0.f; }
#pragma unroll
            for (int ks = 0; ks < 4; ++ks) {
                const bf16x8 a0 = *(const LAS bf16x8*)(kb + r32 * KPITCH + (2 * ks + hi) * 16);
                const bf16x8 a1 = *(const LAS bf16x8*)(kb + (32 + r32) * KPITCH + (2 * ks + hi) * 16);
                p0 = __builtin_amdgcn_mfma_f32_32x32x16_bf16(a0, qf[ks], p0, 0, 0, 0);
                p1 = __builtin_amdgcn_mfma_f32_32x32x16_bf16(a1, qf[ks], p1, 0, 0, 0);
            }
            const bool diag = (T == wstart);
            const int qrel = 32 * (wave & 1) + r32;
            float sp[2][16], xx[2][16];
#pragma unroll
            for (int blk = 0; blk < 2; ++blk)
#pragma unroll
                for (int r = 0; r < 16; ++r) {
                    const float z = blk ? p1[r] : p0[r];
                    const float e1 = __builtin_amdgcn_exp2f(-fabsf(z));
                    float s = fmaxf(z, 0.f) + __builtin_amdgcn_logf(1.0f + e1);
                    if (diag && (32 * blk + crow(r, hi) >= qrel)) s = 0.f;
                    sp[blk][r] = s; xx[blk][r] = z - s;
                }
            float Tq[2][4], lo[2][4];
#pragma unroll
            for (int blk = 0; blk < 2; ++blk)
#pragma unroll
                for (int g = 0; g < 4; ++g) {
                    const float qs = (sp[blk][4 * g] + sp[blk][4 * g + 1]) + (sp[blk][4 * g + 2] + sp[blk][4 * g + 3]);
                    auto rr = __builtin_amdgcn_permlane32_swap(__float_as_uint(qs), __float_as_uint(qs), false, false);
                    const float f0 = __uint_as_float(rr[0]), f1 = __uint_as_float(rr[1]);
                    Tq[blk][g] = f0 + f1; lo[blk][g] = hi ? 0.f : f1;
                }
            float run = carry; float w[2][16];
#pragma unroll
            for (int blk = 1; blk >= 0; --blk)
#pragma unroll
                for (int g = 3; g >= 0; --g) {
                    const float a3 = run + lo[blk][g]; const float a2 = a3 + sp[blk][4 * g + 3]; const float a1 = a2 + sp[blk][4 * g + 2]; const float a0 = a1 + sp[blk][4 * g + 1];
                    w[blk][4 * g + 3] = __builtin_amdgcn_exp2f(xx[blk][4 * g + 3] - a3); w[blk][4 * g + 2] = __builtin_amdgcn_exp2f(xx[blk][4 * g + 2] - a2);
                    w[blk][4 * g + 1] = __builtin_amdgcn_exp2f(xx[blk][4 * g + 1] - a1); w[blk][4 * g + 0] = __builtin_amdgcn_exp2f(xx[blk][4 * g + 0] - a0);
                    run += Tq[blk][g];
                }
            carry = run;
            if (diag) {
#pragma unroll
                for (int blk = 0; blk < 2; ++blk)
#pragma unroll
                    for (int r = 0; r < 16; ++r) if (32 * blk + crow(r, hi) >= qrel) w[blk][r] = 0.f;
            }
            bf16x8 pf[4];
#pragma unroll
            for (int s4 = 0; s4 < 4; ++s4) { const int blk = s4 >> 1, s = s4 & 1; v4u t;
                t.x = cvtpk(w[blk][8 * s + 0], w[blk][8 * s + 1]); t.y = cvtpk(w[blk][8 * s + 2], w[blk][8 * s + 3]); t.z = cvtpk(w[blk][8 * s + 4], w[blk][8 * s + 5]); t.w = cvtpk(w[blk][8 * s + 6], w[blk][8 * s + 7]);
                pf[s4] = __builtin_bit_cast(bf16x8, t); }
#pragma unroll
            for (int s4 = 0; s4 < 4; ++s4) {
#pragma unroll
                for (int d0 = 0; d0 < 2; ++d0) {
                    const LAS unsigned char* vp = vb + d0 * 4096 + s4 * 16 * 64 + vlane;
                    const s16x4 l4 = vtr(vp), h4 = vtr(vp + 8 * 64);
                    const bf16x8 bv = (bf16x8){l4[0], l4[1], l4[2], l4[3], h4[0], h4[1], h4[2], h4[3]};
                    if (d0 == 0) o0 = __builtin_amdgcn_mfma_f32_32x32x16_bf16(pf[s4], bv, o0, 0, 0, 0);
                    else o1 = __builtin_amdgcn_mfma_f32_32x32x16_bf16(pf[s4], bv, o1, 0, 0, 0);
                }
            }
        }
        const int wdone = __all(carry >= A_DONE) ? 1 : 0;
        if (lane == 0) flags[(T & 1) * 8 + wave] = (unsigned)wdone;
        if (T > 0) { *(LAS v4u*)(lds + (cur ^ 1) * BUFSZ + kst) = kreg; *(LAS v4u*)(lds + (cur ^ 1) * BUFSZ + vst) = vreg; }
        LBAR();
        unsigned alld = 1u;
#pragma unroll
        for (int i = 0; i < 8; ++i) alld &= flags[(T & 1) * 8 + i];
        if (alld) break;
        cur ^= 1;
    }
#pragma unroll
    for (int r = 0; r < 16; ++r) {
        bf16* op = O2 + (rowbase + q0w + crow(r, hi)) * 1024 + h * 64 + r32;
        op[0] = (bf16)f2bf(o0[r]); op[32] = (bf16)f2bf(o1[r]);
    }
}
#undef LBAR
}

namespace retn {
#if defined(PROBE_PHASE) && (PROBE_PHASE >= 301) && (PROBE_PHASE <= 303)
#define RPROBE_INIT() volatile LAS unsigned long long* rp_ = (volatile LAS unsigned long long*)(lds + MISC_OFF + 64); unsigned long long rpt_ = __builtin_amdgcn_s_memrealtime()
#define RPROBE(k) do { if (tid == 0) { const unsigned long long t_ = __builtin_amdgcn_s_memrealtime(); if ((k) == PROBE_PHASE) rp_[1] += t_ - rpt_; rpt_ = t_; } } while (0)
#else
#define RPROBE_INIT() do {} while (0)
#define RPROBE(k) do {} while (0)
#endif
#define LBAR() do { asm volatile("s_waitcnt lgkmcnt(0)" ::: "memory"); __builtin_amdgcn_s_barrier(); asm volatile("" ::: "memory"); } while (0)
constexpr int RP = 272;
constexpr int QB_OFF = 0, KB_OFF = 64 * RP, VB_OFF = 2 * 64 * RP, GB_OFF = 3 * 64 * RP, SC_OFF = 4 * 64 * RP, SCP = 144, OB_OFF = SC_OFF + 64 * SCP, OBP = 144, PW_OFF = OB_OFF + 64 * OBP * 4, RET_LDS_END = PW_OFF + 512;
static_assert(RET_LDS_END <= RING_BYTES, "retention LDS");
typedef short s16x4 __attribute__((ext_vector_type(4)));
typedef short v4i16_t __attribute__((ext_vector_type(4)));
typedef unsigned v2u __attribute__((ext_vector_type(2)));
__device__ __forceinline__ s16x4 vtr(const LAS unsigned char* p) { return __builtin_bit_cast(s16x4, __builtin_amdgcn_ds_read_tr16_b64_v4i16((LAS v4i16_t*)p)); }
__device__ __forceinline__ unsigned cvtpk(float lo, float hi) { unsigned r; asm volatile("v_cvt_pk_bf16_f32 %0, %1, %2" : "=v"(r) : "v"(lo), "v"(hi)); return r; }
__device__ __forceinline__ float red8(float v) {
    v += __builtin_bit_cast(float, __builtin_amdgcn_update_dpp(0, __builtin_bit_cast(int, v), 0xB1, 0xF, 0xF, true));
    v += __builtin_bit_cast(float, __builtin_amdgcn_update_dpp(0, __builtin_bit_cast(int, v), 0x4E, 0xF, 0xF, true));
    v += __builtin_bit_cast(float, __builtin_amdgcn_update_dpp(0, __builtin_bit_cast(int, v), 0x141, 0xF, 0xF, true));
    return v;
}
__device__ __forceinline__ bf16x8 cat8(s16x4 a, s16x4 b) { return (bf16x8){a[0], a[1], a[2], a[3], b[0], b[1], b[2], b[3]}; }

#define RET_LOADS_KV(nn) do { const bf16* gs_ = gsrc + (size_t)(nn) * 64 * 2048; \
        kreg[0] = *(const GAS v4u*)(gs_ + 512); kreg[1] = *(const GAS v4u*)(gs_ + 520); vreg[0] = *(const GAS v4u*)(gs_ + 1024); vreg[1] = *(const GAS v4u*)(gs_ + 1032); } while (0)
#define RET_LOADS_QG(nn) do { const bf16* gs_ = gsrc + (size_t)(nn) * 64 * 2048; \
        qreg[0] = *(const GAS v4u*)(gs_); qreg[1] = *(const GAS v4u*)(gs_ + 8); greg[0] = *(const GAS v4u*)(gs_ + 1536); greg[1] = *(const GAS v4u*)(gs_ + 1544); } while (0)
#define RET_STAGE_KV() do { *(LAS v4u*)(lds + KB_OFF + sdst) = kreg[0]; *(LAS v4u*)(lds + KB_OFF + sdst + 16) = kreg[1]; *(LAS v4u*)(lds + VB_OFF + sdst) = vreg[0]; *(LAS v4u*)(lds + VB_OFF + sdst + 16) = vreg[1]; } while (0)
#define RET_STAGE_QG() do { *(LAS v4u*)(lds + QB_OFF + sdst) = qreg[0]; *(LAS v4u*)(lds + QB_OFF + sdst + 16) = qreg[1]; *(LAS v4u*)(lds + GB_OFF + sdst) = greg[0]; *(LAS v4u*)(lds + GB_OFF + sdst + 16) = greg[1]; } while (0)
#define RET_VFRAGS() do { _Pragma("unroll") for (int ks = 0; ks < 2; ++ks) { const LAS unsigned char* p_ = lds + VB_OFF + (32 * ks + 8 * g + trl) * RP + (16 * wave + 4 * trp) * 2; vf[ks] = cat8(vtr(p_), vtr(p_ + 4 * RP)); } } while (0)
#define RET_STATE() do { _Pragma("unroll") for (int d = 0; d < 8; ++d) Sacc[d] = Sacc[d] * g64; \
        _Pragma("unroll") for (int ks = 0; ks < 2; ++ks) _Pragma("unroll") for (int db = 0; db < 8; ++db) { const LAS unsigned char* p_ = lds + KB_OFF + (32 * ks + 8 * g + trl) * RP + (16 * db + 4 * trp) * 2; \
            const bf16x8 a_ = cat8(vtr(p_), vtr(p_ + 4 * RP)); Sacc[db] = __builtin_amdgcn_mfma_f32_16x16x32_bf16(a_, vf[ks], Sacc[db], 0, 0, 0); } } while (0)
__device__ __forceinline__ void ret_unit(LAS unsigned char* lds, const bf16* RET, bf16* O2, int b, int h, int n_begin, int n_end, int tid, int lane, int wave) {
    const int l15 = lane & 15, g = lane >> 4;
    const float gamma = 1.0f - __builtin_amdgcn_exp2f(-5.0f - (float)h);
    const float g64 = __builtin_amdgcn_exp2f(64.0f * __builtin_amdgcn_logf(gamma));
    const int srow = tid >> 3, scp = tid & 7;
    const bf16* gsrc = RET + ((size_t)b * SEQ + srow) * 2048 + h * 128 + scp * 16;
    const int sdst = srow * RP + scp * 32;
    const int nlast = n_end - 1;
    v4u qreg[2], kreg[2], vreg[2], greg[2];
    RET_LOADS_KV(0); RET_LOADS_QG(0);
    __syncthreads();
    RET_STAGE_KV(); RET_STAGE_QG();
    { const int n1 = nlast < 1 ? nlast : 1; RET_LOADS_KV(n1); RET_LOADS_QG(n1); }
    __syncthreads();
    f32x4 Sacc[8];
#pragma unroll
    for (int d = 0; d < 8; ++d) Sacc[d] = (f32x4){0.f, 0.f, 0.f, 0.f};
    const int ct = wave >> 1;
    const int trl = (lane & 15) >> 2, trp = lane & 3;
    RPROBE_INIT();
    bf16x8 vf[2];
    const int npa = n_begin - 2 > 0 ? n_begin - 2 : 0;
    for (int n = 0; n < npa; ++n) {
        RET_VFRAGS();
        RET_STATE();
        LBAR();
        RET_STAGE_KV();
        RET_LOADS_KV(n + 2);
        LBAR();
    }
    for (int n = npa; n < n_begin; ++n) {
        RET_VFRAGS();
        RET_STATE();
        LBAR();
        RET_STAGE_KV(); RET_STAGE_QG();
        { const int n2 = n + 2 < nlast ? n + 2 : nlast; RET_LOADS_KV(n2); RET_LOADS_QG(n2); }
        LBAR();
    }
    for (int n = n_begin; n < n_end; ++n) {
        RPROBE(0);
        {
            const int mt0 = 2 * (wave & 1);
            f32x4 acc0 = (f32x4){0.f, 0.f, 0.f, 0.f}, acc1 = (f32x4){0.f, 0.f, 0.f, 0.f};
            if (mt0 <= ct) {
#pragma unroll
                for (int ks = 0; ks < 4; ++ks) {
                    const bf16x8 a = *(const LAS bf16x8*)(lds + QB_OFF + (16 * ct + l15) * RP + 64 * ks + 16 * g);
                    const bf16x8 b0 = *(const LAS bf16x8*)(lds + KB_OFF + (16 * mt0 + l15) * RP + 64 * ks + 16 * g);
                    const bf16x8 b1 = *(const LAS bf16x8*)(lds + KB_OFF + (16 * (mt0 + 1) + l15) * RP + 64 * ks + 16 * g);
                    acc0 = __builtin_amdgcn_mfma_f32_16x16x32_bf16(b0, a, acc0, 0, 0, 0);
                    acc1 = __builtin_amdgcn_mfma_f32_16x16x32_bf16(b1, a, acc1, 0, 0, 0);
                }
            }
            const int c = 16 * ct + l15;
#pragma unroll
            for (int t = 0; t < 2; ++t) {
                const int m0 = 16 * (mt0 + t) + 4 * g; const f32x4 av = t ? acc1 : acc0;
                const float v0 = (c >= m0) ? av[0] : 0.f, v1 = (c >= m0 + 1) ? av[1] : 0.f, v2 = (c >= m0 + 2) ? av[2] : 0.f, v3 = (c >= m0 + 3) ? av[3] : 0.f;
                v2u w; w.x = cvtpk(v0, v1); w.y = cvtpk(v2, v3);
                *(LAS v2u*)(lds + SC_OFF + c * SCP + m0 * 2) = w;
            }
        }
        LBAR();
        RPROBE(301);
        RET_VFRAGS();
        {
            f32x4 oacc[4], cacc[4];
#pragma unroll
            for (int cb = 0; cb < 4; ++cb) { oacc[cb] = (f32x4){0.f, 0.f, 0.f, 0.f}; cacc[cb] = (f32x4){0.f, 0.f, 0.f, 0.f}; }
#pragma unroll
            for (int ks = 0; ks < 2; ++ks)
#pragma unroll
                for (int cb = 0; cb < 4; ++cb) if (32 * ks <= 16 * cb + 15) {
                    const bf16x8 a = *(const LAS bf16x8*)(lds + SC_OFF + (16 * cb + l15) * SCP + 64 * ks + 16 * g);
                    oacc[cb] = __builtin_amdgcn_mfma_f32_16x16x32_bf16(a, vf[ks], oacc[cb], 0, 0, 0);
                }
            bf16x8 bs[4];
#pragma unroll
            for (int ks = 0; ks < 4; ++ks) { v4u t; t.x = cvtpk(Sacc[2 * ks][0], Sacc[2 * ks][1]); t.y = cvtpk(Sacc[2 * ks][2], Sacc[2 * ks][3]); t.z = cvtpk(Sacc[2 * ks + 1][0], Sacc[2 * ks + 1][1]); t.w = cvtpk(Sacc[2 * ks + 1][2], Sacc[2 * ks + 1][3]);
                bs[ks] = __builtin_bit_cast(bf16x8, t); }
#pragma unroll
            for (int ks = 0; ks < 4; ++ks)
#pragma unroll
                for (int cb = 0; cb < 4; ++cb) {
                    const LAS unsigned char* p = lds + QB_OFF + (16 * cb + l15) * RP + 64 * ks + 8 * g;
                    const v2u lo = *(const LAS v2u*)p, hi2 = *(const LAS v2u*)(p + 32);
                    const bf16x8 a = __builtin_bit_cast(bf16x8, (v4u){lo.x, lo.y, hi2.x, hi2.y});
                    cacc[cb] = __builtin_amdgcn_mfma_f32_16x16x32_bf16(a, bs[ks], cacc[cb], 0, 0, 0);
                }
#pragma unroll
            for (int cb = 0; cb < 4; ++cb)
#pragma unroll
                for (int i = 0; i < 4; ++i) { const int c = 16 * cb + 4 * g + i;
                    *(LAS float*)(lds + OB_OFF + (c * OBP + 16 * wave + l15) * 4) = oacc[cb][i] + g64 * cacc[cb][i]; }
        }
        RET_STATE();
        LBAR();
        RPROBE(302);
        {
            const LAS float* op = (const LAS float*)(lds + OB_OFF + (srow * OBP + 16 * scp) * 4);
            float ov[16];
#pragma unroll
            for (int i = 0; i < 4; ++i) { const f32x4 t = *(const LAS f32x4*)(op + 4 * i); ov[4 * i] = t[0]; ov[4 * i + 1] = t[1]; ov[4 * i + 2] = t[2]; ov[4 * i + 3] = t[3]; }
            float sm = 0.f;
#pragma unroll
            for (int i = 0; i < 16; ++i) sm += ov[i];
            const float mean = red8(sm) * (1.f / 128.f);
            float q2 = 0.f;
#pragma unroll
            for (int i = 0; i < 16; ++i) { ov[i] -= mean; q2 += ov[i] * ov[i]; }
            const float rstd = 1.0f / sqrtf(red8(q2) * (1.f / 128.f) + GN_EPS);
            float gf[16];
            { const v4u w0 = *(const LAS v4u*)(lds + GB_OFF + sdst), w1 = *(const LAS v4u*)(lds + GB_OFF + sdst + 16);
              gf[0] = __uint_as_float(w0.x << 16); gf[1] = __uint_as_float(w0.x & 0xffff0000u); gf[2] = __uint_as_float(w0.y << 16); gf[3] = __uint_as_float(w0.y & 0xffff0000u);
              gf[4] = __uint_as_float(w0.z << 16); gf[5] = __uint_as_float(w0.z & 0xffff0000u); gf[6] = __uint_as_float(w0.w << 16); gf[7] = __uint_as_float(w0.w & 0xffff0000u);
              gf[8] = __uint_as_float(w1.x << 16); gf[9] = __uint_as_float(w1.x & 0xffff0000u); gf[10] = __uint_as_float(w1.y << 16); gf[11] = __uint_as_float(w1.y & 0xffff0000u);
              gf[12] = __uint_as_float(w1.z << 16); gf[13] = __uint_as_float(w1.z & 0xffff0000u); gf[14] = __uint_as_float(w1.w << 16); gf[15] = __uint_as_float(w1.w & 0xffff0000u); }
            float r[16];
#pragma unroll
            for (int i = 0; i < 16; ++i) r[i] = ov[i] * rstd * gf[i] * pg8::fast_sigmoid(gf[i]);
            bf16* orow = O2 + ((size_t)b * SEQ + 64 * n + srow) * 1024 + 512 + h * 128 + 16 * scp;
            v4u wa, wb; wa.x = cvtpk(r[0], r[1]); wa.y = cvtpk(r[2], r[3]); wa.z = cvtpk(r[4], r[5]); wa.w = cvtpk(r[6], r[7]);
            wb.x = cvtpk(r[8], r[9]); wb.y = cvtpk(r[10], r[11]); wb.z = cvtpk(r[12], r[13]); wb.w = cvtpk(r[14], r[15]);
            asm volatile("" : "+v"(wa), "+v"(wb));
            *(GAS v4u*)orow = wa; *(GAS v4u*)(orow + 8) = wb;
        }
        RET_STAGE_KV(); RET_STAGE_QG();
        { const int n2 = n + 2 < nlast ? n + 2 : nlast; RET_LOADS_KV(n2); RET_LOADS_QG(n2); }
        LBAR();
        RPROBE(303);
    }
}
#undef RET_LOADS_KV
#undef RET_LOADS_QG
#undef RET_STAGE_KV
#undef RET_STAGE_QG
#undef RET_VFRAGS
#undef RET_STATE
#undef LBAR
}

struct Frame {
    LAS unsigned char* lds;
    volatile LAS unsigned* MISC;
    gu32* ctl;
    int tid, lane, wave;
    int vcu, G;
    const float* x; float* out;
    const float *g_ffn1_pre, *g_ffn1_post, *w1g, *w1u, *w1d, *g_mix_pre, *w_in, *w_psb, *w_pret, *w_out, *g_mix_post, *g_ffn2_pre, *g_ffn2_post, *w2g, *w2u, *w2d;
    unsigned char* ws;
};


__device__ __forceinline__ void tr_block(const float* W, int ldw, int k0, int n0, bf16* WT, int ldt, int drow0, int dk0, LAS float* scr, int lane) {
#pragma unroll 8
    for (int i = 0; i < 32; ++i) { const int kk = 2 * i + (lane >> 5); scr[kk * 33 + (lane & 31)] = W[(size_t)(k0 + kk) * ldw + n0 + (lane & 31)]; }
    LDS_WAIT(); asm volatile("" ::: "memory");
    const int c = lane & 7;
#pragma unroll
    for (int j = 0; j < 4; ++j) { const int n = (lane >> 3) + 8 * j; const LAS float* s = scr + (8 * c) * 33 + n;
        v4u o; o.x = pk2(s[0 * 33], s[1 * 33]); o.y = pk2(s[2 * 33], s[3 * 33]); o.z = pk2(s[4 * 33], s[5 * 33]); o.w = pk2(s[6 * 33], s[7 * 33]);
        *(GAS v4u*)(WT + (size_t)(drow0 + n) * ldt + dk0 + 8 * c) = o; }
    LDS_WAIT(); asm volatile("" ::: "memory");
}
__device__ __forceinline__ void tr_job(int kind, const float* W, int K, int N, bf16* WT, int ldt, int item, LAS float* scr, int lane) {
    const int nblk = N / 32, kb = item / nblk, nb = item % nblk, k0 = 64 * kb, n0 = 32 * nb;
    int drow0 = n0, dk0 = k0;
    if (kind == 1) drow0 = 256 * (n0 >> 7) + (n0 & 127);
    else if (kind == 2) drow0 = 256 * (n0 >> 7) + 128 + (n0 & 127);
    else if (kind == 3) { const int tile = n0 >> 8; if (tile >= 6 && tile < 10) { const int local = n0 & 255, hl = local >> 7, within = local & 127, half = within >> 6, i0 = within & 63; drow0 = 256 * tile + 128 * half + 64 * hl + i0; } }
    else if (kind == 4) drow0 = 256 * (n0 >> 7) + (n0 & 127);
    else if (kind == 5) { drow0 = 256 * (n0 >> 7) + 128 + (n0 & 127); dk0 = 512 + k0; }
    tr_block(W, N, k0, n0, WT, ldt, drow0, dk0, scr, lane);
}

__device__ __forceinline__ void rms_to_bf16(const f32x4 (&v)[4], const float* g, bf16* orow, int lane) {
    float s = 0.f;
#pragma unroll
    for (int j = 0; j < 4; ++j) s += (v[j].x * v[j].x + v[j].y * v[j].y) + (v[j].z * v[j].z + v[j].w * v[j].w);
    const float rs = 1.0f / sqrtf(wave_sum(s) * (1.f / D) + RMS_EPS);
    GAS unsigned long long* o8 = (GAS unsigned long long*)orow + lane;
#pragma unroll
    for (int j = 0; j < 4; ++j) { const f32x4 gg = ((const GAS f32x4*)g)[lane + 64 * j];
        o8[64 * j] = (unsigned long long)pk2(v[j].x * rs * gg.x, v[j].y * rs * gg.y) | ((unsigned long long)pk2(v[j].z * rs * gg.z, v[j].w * rs * gg.w) << 32); }
}
__device__ __forceinline__ void rows_phase(Frame& F, const float* Y, const float* xres, float* xo, const float* g_post, float coef, const float* g_pre, bf16* hn) {
    const int gw = F.vcu * NWAVES + F.wave, NGW = F.G * NWAVES;
    for (int m = gw; m < M; m += NGW) {
        const GAS f32x4* yr = (const GAS f32x4*)(Y + (size_t)m * D) + F.lane;
        const GAS f32x4* xr = (const GAS f32x4*)(xres + (size_t)m * D) + F.lane;
        f32x4 y[4], xv[4]; float s = 0.f;
#pragma unroll
        for (int j = 0; j < 4; ++j) { y[j] = yr[64 * j]; xv[j] = xr[64 * j]; s += (y[j].x * y[j].x + y[j].y * y[j].y) + (y[j].z * y[j].z + y[j].w * y[j].w); }
        const float rs = coef / sqrtf(wave_sum(s) * (1.f / D) + RMS_EPS);
        GAS f32x4* orow = (GAS f32x4*)(xo + (size_t)m * D) + F.lane;
#pragma unroll
        for (int j = 0; j < 4; ++j) { const f32x4 gg = ((const GAS f32x4*)g_post)[F.lane + 64 * j]; xv[j] = xv[j] + y[j] * gg * rs; orow[64 * j] = xv[j]; }
        if (hn) rms_to_bf16(xv, g_pre, hn + (size_t)m * D, F.lane);
    }
}

__device__ __forceinline__ void convert_ffn_weights(Frame& F, const float* wg, const float* wu, const float* wd, LAS float* scr) {
    const int gw = F.vcu * NWAVES + F.wave, NGW = F.G * NWAVES;
    bf16* WGU = (bf16*)(F.ws + WS_WGU); bf16* WD = (bf16*)(F.ws + WS_WD);
    constexpr int I_G = (D / 64) * (FF / 32), I_D = (FF / 64) * (D / 32);
    for (int it = gw; it < 2 * I_G + I_D; it += NGW) {
        int r = it;
        if (r < I_G) { tr_job(1, wg, D, FF, WGU, D, r, scr, F.lane); continue; } r -= I_G;
        if (r < I_G) { tr_job(2, wu, D, FF, WGU, D, r, scr, F.lane); continue; } r -= I_G;
        tr_job(0, wd, FF, D, WD, FF, r, scr, F.lane);
    }
}

__device__ __forceinline__ void p0_prologue(Frame& F) {
    LAS float* scr = (LAS float*)(F.lds + RING_OFF + F.wave * 16384);
    const int gw = F.vcu * NWAVES + F.wave, NGW = F.G * NWAVES;
    convert_ffn_weights(F, F.w1g, F.w1u, F.w1d, scr);
    bf16* WIN = (bf16*)(F.ws + WS_WIN); bf16* WP = (bf16*)(F.ws + WS_WP); bf16* WOUT = (bf16*)(F.ws + WS_WOUT);
    constexpr int I_IN = (D / 64) * (NPROJ / 32), I_P = (512 / 64) * (D / 32), I_O = (D / 64) * (D / 32);
    for (int it = gw; it < I_IN + 2 * I_P + I_O; it += NGW) {
        int r = it;
        if (r < I_IN) { tr_job(3, F.w_in, D, NPROJ, WIN, D, r, scr, F.lane); continue; } r -= I_IN;
        if (r < I_P) { tr_job(4, F.w_psb, 512, D, WP, D, r, scr, F.lane); continue; } r -= I_P;
        if (r < I_P) { tr_job(5, F.w_pret, 512, D, WP, D, r, scr, F.lane); continue; } r -= I_P;
        tr_job(0, F.w_out, D, D, WOUT, D, r, scr, F.lane);
    }
    for (int r = gw; r < 2048; r += NGW) { const int kz = ((r & 255) < 128) ? 512 : 0; *(GAS v4u*)(WP + (size_t)r * 1024 + kz + 8 * F.lane) = (v4u){0u, 0u, 0u, 0u}; }
    { float* ct = (float*)(F.ws + WS_ROPE); float* st = ct + 2048 * 64;
      for (int idx = (F.vcu * NWAVES + F.wave) * 64 + F.lane; idx < 2048 * 64; idx += F.G * NWAVES * 64) {
          const int pos = idx >> 6, i = idx & 63;
          const float inv_freq = exp2f(-(float)i * (13.287712379549449f / 64.0f));
          const float ang = (float)pos * inv_freq;
          const double a = (double)ang; const double k = __builtin_rint(a * 0.15915494309189535);
          const double r = __builtin_fma(-k, 6.283185307179586, a) - k * 2.4492935982947064e-16;
          const float rf = (float)r; ct[idx] = cosf(rf); st[idx] = sinf(rf); } }
    bf16* H = (bf16*)(F.ws + WS_H);
    for (int m = gw; m < M; m += NGW) { const GAS f32x4* xr = (const GAS f32x4*)(F.x + (size_t)m * D) + F.lane; f32x4 v[4];
#pragma unroll
        for (int j = 0; j < 4; ++j) v[j] = xr[64 * j];
        rms_to_bf16(v, F.g_ffn1_pre, H + (size_t)m * D, F.lane); }
}

__device__ __forceinline__ void unpack8(const v4u w, float* f) {
    f[0] = __uint_as_float(w.x << 16); f[1] = __uint_as_float(w.x & 0xffff0000u); f[2] = __uint_as_float(w.y << 16); f[3] = __uint_as_float(w.y & 0xffff0000u);
    f[4] = __uint_as_float(w.z << 16); f[5] = __uint_as_float(w.z & 0xffff0000u); f[6] = __uint_as_float(w.w << 16); f[7] = __uint_as_float(w.w & 0xffff0000u);
}
__device__ __forceinline__ float bf2f(bf16 v) { return __uint_as_float((unsigned)v << 16); }

__device__ __forceinline__ void attn_naive(Frame& F) {
    const bf16* QKVS = (const bf16*)(F.ws + WS_QKVS); bf16* O2 = (bf16*)(F.ws + WS_H);
    const int bx = blockIdx.x;
    for (int bh = bx >> 2; bh < 64; bh += (F.G >> 2)) {
        const int q4 = bx & 3, wv = F.wave;
        const int tb = wv < 4 ? q4 * 4 + wv : 31 - (q4 * 4 + (wv - 4));
        const int t = tb * 64 + F.lane, b = bh >> 3, h = bh & 7;
        const bf16* base = QKVS + (size_t)(b * SEQ) * 1536 + h * 64;
        float q[64], acc[64];
        { const GAS v4u* qp = (const GAS v4u*)(base + (size_t)t * 1536);
#pragma unroll
          for (int j = 0; j < 8; ++j) unpack8(qp[j], q + 8 * j); }
#pragma unroll
        for (int j = 0; j < 64; ++j) acc[j] = 0.f;
        float between = 0.f;
        for (int s = t - 1; s >= 0; --s) {
            const GAS v4u* kp = (const GAS v4u*)(base + (size_t)s * 1536 + 512);
            const GAS v4u* vp = (const GAS v4u*)(base + (size_t)s * 1536 + 1024);
            float z = 0.f;
#pragma unroll
            for (int j = 0; j < 8; ++j) { float kf[8]; unpack8(kp[j], kf);
#pragma unroll
                for (int e = 0; e < 8; ++e) z += q[8 * j + e] * kf[e]; }
            const float lk = -(fmaxf(z, 0.f) + __logf(1.0f + __expf(-fabsf(z))));
            const float w = __expf(z + lk + between);
#pragma unroll
            for (int j = 0; j < 8; ++j) { float vf[8]; unpack8(vp[j], vf);
#pragma unroll
                for (int e = 0; e < 8; ++e) acc[8 * j + e] += w * vf[e]; }
            between += lk;
        }
        GAS v4u* op = (GAS v4u*)(O2 + (size_t)(b * SEQ + t) * 1024 + h * 64);
#pragma unroll
        for (int j = 0; j < 8; ++j) { v4u w; w.x = pk2(acc[8 * j], acc[8 * j + 1]); w.y = pk2(acc[8 * j + 2], acc[8 * j + 3]); w.z = pk2(acc[8 * j + 4], acc[8 * j + 5]); w.w = pk2(acc[8 * j + 6], acc[8 * j + 7]); op[j] = w; }
    }
}

__device__ __forceinline__ void ret_naive(Frame& F) {
    const bf16* RET = (const bf16*)(F.ws + WS_RET); bf16* O2 = (bf16*)(F.ws + WS_H);
    LAS float* red = (LAS float*)(F.lds + RING_OFF);
    for (int bh = blockIdx.x; bh < 32; bh += F.G) {
        const int b = bh >> 2, h = bh & 3;
        const float gamma = 1.0f - exp2f(-5.0f - (float)h);
        const int e = F.tid & 127, dg = F.tid >> 7;
        float S[32];
#pragma unroll
        for (int i = 0; i < 32; ++i) S[i] = 0.f;
        for (int t0 = 0; t0 < SEQ; t0 += 8) {
#pragma unroll 1
            for (int j = 0; j < 8; ++j) {
                const bf16* row = RET + (size_t)(b * SEQ + t0 + j) * 2048;
                const float vv = bf2f(row[1024 + h * 128 + e]);
                const GAS v4u* qp = (const GAS v4u*)(row + h * 128 + 32 * dg);
                const GAS v4u* kp = (const GAS v4u*)(row + 512 + h * 128 + 32 * dg);
                float p = 0.f;
#pragma unroll
                for (int c = 0; c < 4; ++c) { float qf[8], kf[8]; unpack8(qp[c], qf); unpack8(kp[c], kf);
#pragma unroll
                    for (int i = 0; i < 8; ++i) { S[8 * c + i] = gamma * S[8 * c + i] + kf[i] * vv; p += qf[i] * S[8 * c + i]; } }
                red[(j * 4 + dg) * 128 + e] = p;
            }
            __syncthreads();
            { const int j = F.wave; const bf16* row = RET + (size_t)(b * SEQ + t0 + j) * 2048;
              const float o0 = (red[(j * 4 + 0) * 128 + F.lane] + red[(j * 4 + 1) * 128 + F.lane]) + (red[(j * 4 + 2) * 128 + F.lane] + red[(j * 4 + 3) * 128 + F.lane]);
              const float o1 = (red[(j * 4 + 0) * 128 + 64 + F.lane] + red[(j * 4 + 1) * 128 + 64 + F.lane]) + (red[(j * 4 + 2) * 128 + 64 + F.lane] + red[(j * 4 + 3) * 128 + 64 + F.lane]);
              const float mean = wave_sum(o0 + o1) * (1.f / 128.f); const float d0 = o0 - mean, d1 = o1 - mean;
              const float var = wave_sum(d0 * d0 + d1 * d1) * (1.f / 128.f); const float rstd = 1.0f / sqrtf(var + GN_EPS);
              const float g0 = bf2f(row[1536 + h * 128 + F.lane]), g1 = bf2f(row[1536 + h * 128 + 64 + F.lane]);
              bf16* orow = O2 + (size_t)(b * SEQ + t0 + j) * 1024 + 512 + h * 128;
              orow[F.lane] = (bf16)f2bf(d0 * rstd * g0 * pg8::fast_sigmoid(g0)); orow[64 + F.lane] = (bf16)f2bf(d1 * rstd * g1 * pg8::fast_sigmoid(g1)); }
            __syncthreads();
        }
    }
}

struct Args { const float* in[17]; float* out; unsigned char* ws; int ph_lo, ph_hi, li, pad; };
__global__ void __launch_bounds__(NWAVES * 64, 2) skel_fwd(Args args) {
    extern __shared__ __attribute__((aligned(16))) unsigned char lds[];
    Frame F;
    F.lds = (LAS unsigned char*)lds;
    F.MISC = (volatile LAS unsigned*)(F.lds + MISC_OFF);
    F.tid = threadIdx.x; F.lane = F.tid & 63; F.wave = __builtin_amdgcn_readfirstlane(F.tid >> 6);
    F.G = gridDim.x; { const int bx = blockIdx.x; F.vcu = (F.G % 8 == 0) ? (bx % 8) * (F.G / 8) + bx / 8 : bx; }
#define GRID_BAR(seam) do { if (N_LAUNCHES == NPHASE) { if (F.tid == 0) __hip_atomic_store(F.ctl + CW_TMO, 0xBADBA0u | (unsigned)(seam), RLX_AGENT); } \
    else { xcd_barrier(bar); } } while (0)
    unsigned char* ws = args.ws; F.ws = ws;
    F.ctl = (gu32*)(ws + WS_CTL);
    F.x = args.in[0]; F.g_ffn1_pre = args.in[1]; F.g_ffn1_post = args.in[2]; F.w1g = args.in[3]; F.w1u = args.in[4]; F.w1d = args.in[5];
    F.g_mix_pre = args.in[6]; F.w_in = args.in[7]; F.w_psb = args.in[8]; F.w_pret = args.in[9]; F.w_out = args.in[10]; F.g_mix_post = args.in[11];
    F.g_ffn2_pre = args.in[12]; F.g_ffn2_post = args.in[13]; F.w2g = args.in[14]; F.w2u = args.in[15]; F.w2d = args.in[16]; F.out = args.out;
    for (int u = F.tid; u < (LDS_BYTES - LDSCTL_OFF) / 4; u += NWAVES * 64) ((LAS unsigned*)(F.lds + LDSCTL_OFF))[u] = 0u;
    __syncthreads();
    XcdBarrier bar; bar.bar = (unsigned*)(F.ctl + CW_BAR); bar.x = 0; bar.st = nullptr;
    if (N_LAUNCHES != NPHASE) bar = xcd_barrier_post((unsigned*)(F.ctl + CW_BAR), F.MISC + 8);

    const int lo = args.ph_lo, hi = args.ph_hi;
#if defined(PROBE_PHASE)
#ifndef PROBE_BLOCK
#define PROBE_BLOCK 0
#endif
    volatile LAS unsigned long long* pst = (volatile LAS unsigned long long*)(F.lds + MISC_OFF + 64);
#define PH_BEGIN(k) do { if ((k) == PROBE_PHASE && blockIdx.x == PROBE_BLOCK && F.tid == 0) pst[0] = rt(); } while (0)
#define PH_END(k) do { if ((k) == PROBE_PHASE && blockIdx.x == PROBE_BLOCK && F.tid == 0) pst[1] = rt() - pst[0]; } while (0)
#else
#define PH_BEGIN(k) do {} while (0)
#define PH_END(k) do {} while (0)
#endif
#define IN(k) (lo <= (k) && (k) < hi)
#define BOTH(k) (IN(k) && IN((k) + 1))
    bf16* H = (bf16*)(ws + WS_H);
    bf16* ACT = (bf16*)(ws + WS_ACT);

    if (IN(0)) { PH_BEGIN(0); p0_prologue(F); if (BOTH(0)) GRID_BAR(0); PH_END(0); }
    if (IN(1)) { PH_BEGIN(1); pg8::Gemm g{H, (const bf16*)(ws + WS_WGU), M, 2 * FF, D}; pg8::StaticOrder S; S.init(M, 2 * FF, F.G, (int)blockIdx.x);
        pg8::EpiSwiGLU E{ACT, FF};
        pg8::gemm_phase<pg8::EpiSwiGLU, pg8::StaticOrder, true, true>(F.lds + RING_OFF, g, S, E);
        if (BOTH(1)) GRID_BAR(1); PH_END(1); }
    if (IN(2)) { PH_BEGIN(2); pg8::Gemm g{ACT, (const bf16*)(ws + WS_WD), M, D, FF}; pg8::StaticOrder S; S.init(M, D, F.G, (int)blockIdx.x);
        pg8::EpiF32 E{F.out, D};
        pg8::gemm_phase<pg8::EpiF32, pg8::StaticOrder, true, true>(F.lds + RING_OFF, g, S, E);
        if (BOTH(2)) GRID_BAR(2); PH_END(2); }
    if (IN(3)) { PH_BEGIN(3); rows_phase(F, F.out, F.x, F.out, F.g_ffn1_post, 0.5f, F.g_mix_pre, H);
        convert_ffn_weights(F, F.w2g, F.w2u, F.w2d, (LAS float*)(F.lds + RING_OFF + F.wave * 16384));
        if (BOTH(3)) GRID_BAR(3); PH_END(3); }
    if (IN(4)) { PH_BEGIN(4); pg8::Gemm g{H, (const bf16*)(ws + WS_WIN), M, NPROJ, D}; pg8::StaticOrder S; S.init(M, NPROJ, F.G, (int)blockIdx.x);
        pg8::EpiProj E{(bf16*)(ws + WS_QKVS), (bf16*)(ws + WS_RET), (bf16*)(ws + WS_GATES), (const float*)(ws + WS_ROPE), (const float*)(ws + WS_ROPE) + 2048 * 64};
        pg8::gemm_phase<pg8::EpiProj, pg8::StaticOrder, true, true>(F.lds + RING_OFF, g, S, E);
        if (BOTH(4)) GRID_BAR(4); PH_END(4); }
    if (IN(5)) { PH_BEGIN(5);
        PH_BEGIN(105); PH_BEGIN(205);
        for (int it = (int)blockIdx.x; it < 256; it += F.G) {
            const int xcd = it & 7, idx = it >> 3, bh = xcd * 4 + (idx >> 3), rk = idx & 7;
            const int rs = (0x1e1c1916120d0700ull >> (8 * rk)) & 0xff, re = (rk == 7) ? 32 : (int)((0x1e1c1916120d0700ull >> (8 * (rk + 1))) & 0xff);
            retn::ret_unit(F.lds + RING_OFF, (const bf16*)(ws + WS_RET), H, bh >> 2, bh & 3, rs, re, F.tid, F.lane, F.wave);
        }
        PH_END(205);
        for (int it = (int)blockIdx.x; it < 256; it += F.G) {
            const int xcd = it & 7, idx = it >> 3, bh = xcd * 8 + (idx >> 2), qa = idx & 3;
            sba::attn_unit(F.lds + RING_OFF, (const bf16*)(ws + WS_QKVS), H, bh >> 3, bh & 7, 7 - qa, F.tid, F.lane, F.wave);
            sba::attn_unit(F.lds + RING_OFF, (const bf16*)(ws + WS_QKVS), H, bh >> 3, bh & 7, qa, F.tid, F.lane, F.wave);
        }
        PH_END(105);
        if (BOTH(5)) GRID_BAR(5); PH_END(5); }
    if (IN(6)) { PH_BEGIN(6); pg8::Gemm g{H, (const bf16*)(ws + WS_WP), M, 2 * D, D}; pg8::StaticOrder S; S.init(M, 2 * D, F.G, (int)blockIdx.x);
        pg8::EpiMerge E{(bf16*)(ws + WS_MERGED), (const bf16*)(ws + WS_GATES)};
        pg8::gemm_phase<pg8::EpiMerge, pg8::StaticOrder, true, true>(F.lds + RING_OFF, g, S, E);
        if (BOTH(6)) GRID_BAR(6); PH_END(6); }
    if (IN(7)) { PH_BEGIN(7); pg8::Gemm g{(const bf16*)(ws + WS_MERGED), (const bf16*)(ws + WS_WOUT), M, D, D}; pg8::StaticOrder S; S.init(M, D, F.G, (int)blockIdx.x);
        pg8::EpiF32 E{(float*)(ws + WS_Z), D};
        pg8::gemm_phase<pg8::EpiF32, pg8::StaticOrder, true, true>(F.lds + RING_OFF, g, S, E);
        if (BOTH(7)) GRID_BAR(7); PH_END(7); }
    if (IN(8)) { PH_BEGIN(8); rows_phase(F, (const float*)(ws + WS_Z), F.out, F.out, F.g_mix_post, 1.0f, F.g_ffn2_pre, H); if (BOTH(8)) GRID_BAR(8); PH_END(8); }
    if (IN(9)) { PH_BEGIN(9); pg8::Gemm g{H, (const bf16*)(ws + WS_WGU), M, 2 * FF, D}; pg8::StaticOrder S; S.init(M, 2 * FF, F.G, (int)blockIdx.x);
        pg8::EpiSwiGLU E{ACT, FF};
        pg8::gemm_phase<pg8::EpiSwiGLU, pg8::StaticOrder, true, true>(F.lds + RING_OFF, g, S, E);
        if (BOTH(9)) GRID_BAR(9); PH_END(9); }
    if (IN(10)) { PH_BEGIN(10); pg8::Gemm g{ACT, (const bf16*)(ws + WS_WD), M, D, FF}; pg8::StaticOrder S; S.init(M, D, F.G, (int)blockIdx.x);
        pg8::EpiF32 E{(float*)(ws + WS_Y2), D};
        pg8::gemm_phase<pg8::EpiF32, pg8::StaticOrder, true, true>(F.lds + RING_OFF, g, S, E);
        if (BOTH(10)) GRID_BAR(10); PH_END(10); }
    if (IN(11)) { PH_BEGIN(11); rows_phase(F, (const float*)(ws + WS_Y2), F.out, F.out, F.g_ffn2_post, 0.5f, nullptr, nullptr); PH_END(11); }
#if defined(PROBE_PHASE)
    if (blockIdx.x == PROBE_BLOCK && F.tid == 0) { const unsigned long long ts = rt(); const unsigned long long pdur = pst[1]; while (rt() - ts < (unsigned long long)PROBE_MULT * pdur) __builtin_amdgcn_s_sleep(8); }
#endif
#undef IN
#undef BOTH
}

extern "C" void kernel_launch(void* const* d_in, const int* in_sizes, int n_in, void* d_out, int out_size, void* d_ws, size_t ws_size, hipStream_t stream) {
    static int grid = 0;
    if (grid == 0) {
        if (n_in != 17 || in_sizes[0] != M * D || out_size != M * D || ws_size < WS_END) { fprintf(stderr, "kernel_launch: unexpected shapes: n_in %d in0 %d out %d ws %zu (need %zu)\n", n_in, n_in > 0 ? in_sizes[0] : -1, out_size, ws_size, (size_t)WS_END); grid = -1; return; }
        int dev = 0, cus = 0, per_cu = 0;
        if (hipGetDevice(&dev) != hipSuccess || hipDeviceGetAttribute(&cus, hipDeviceAttributeMultiprocessorCount, dev) != hipSuccess) { fprintf(stderr, "kernel_launch: device query failed\n"); grid = -1; return; }
        if (hipFuncSetAttribute((const void*)skel_fwd, hipFuncAttributeMaxDynamicSharedMemorySize, LDS_BYTES) != hipSuccess) { fprintf(stderr, "kernel_launch: hipFuncSetAttribute failed\n"); grid = -1; return; }
        if (hipOccupancyMaxActiveBlocksPerMultiprocessor(&per_cu, (const void*)skel_fwd, NWAVES * 64, LDS_BYTES) != hipSuccess || per_cu < 1)
            fprintf(stderr, "kernel_launch: note: occupancy query reports %d workgroups per CU\n", per_cu);
        (void)hipGetLastError();
        grid = cus;
        if (grid > 256) grid = 256;
    }
    if (grid < 0) return;
    if (hipMemsetAsync((char*)d_ws + WS_CTL, 0, CTL_ZERO_BYTES, stream) != hipSuccess) { fprintf(stderr, "kernel_launch: memset failed\n"); return; }
    Args a{};
    for (int i = 0; i < 17; ++i) a.in[i] = (const float*)d_in[i];
    a.out = (float*)d_out; a.ws = (unsigned char*)d_ws;
    for (int li = 0; li < N_LAUNCHES; ++li) {
        a.ph_lo = (N_LAUNCHES == NPHASE) ? li : 0; a.ph_hi = (N_LAUNCHES == NPHASE) ? li + 1 : NPHASE; a.li = li;
        hipLaunchKernelGGL(skel_fwd, dim3(grid), dim3(NWAVES * 64), LDS_BYTES, stream, a);
        const hipError_t le = hipPeekAtLastError();
        if (le != hipSuccess) { fprintf(stderr, "kernel_launch: launch %d failed: %s\n", li, hipGetErrorName(le)); break; }
    }
}
```
